# Optimizing an MI355X kernel written in HIP

```python
import jax, jax.numpy as jnp
from jax import lax
import numpy as np

D_MODEL = 1024
BATCH = 8
SEQ = 2048
DEPTH = 2
DEC_BATCH = 128
DEC_SEQ = 8
PAST_LEN = 16384
PAGE_SIZE = 128

MIX = D_MODEL
W_A = MIX // 4
W_B = MIX // 4
W_C = MIX // 4
W_D = MIX - W_A - W_B - W_C
K_A = 3
H_B = 4
DV = W_B // H_B
DK = DV // 2
GATE_RANK = 16
GATE_TAU = 16.0
GLA_CHUNK = 16
K_C = 31
H_D = 4
D_CHUNK = 128
D_FF = 4 * D_MODEL
ALPHA = (2 * DEPTH) ** 0.25
BETA = (8 * DEPTH) ** -0.25
LN_EPS = 1e-5
SEG = (3 * W_A, H_B * DK, H_B * DK, W_B, W_B, GATE_RANK, 2 * W_C, 2 * W_D)
IN_COLS = int(sum(SEG))
SPLIT_AT = tuple(int(s) for s in np.cumsum(SEG)[:-1])

kernel_name = 'hymba_style_conv_gla_conformer_gmlp_step'


def layer_norm(x, g, b):
    xf = x.astype(jnp.float32)
    mu = jnp.mean(xf, -1, keepdims=True)
    var = jnp.mean(jnp.square(xf - mu), -1, keepdims=True)
    return ((xf - mu) * lax.rsqrt(var + LN_EPS)).astype(x.dtype) * g + b


def causal_dwconv(xp, w):
    return lax.conv_general_dilated(xp, w[:, None, :], window_strides=(1,), padding='VALID',
                                    dimension_numbers=('NWC', 'WIO', 'NWC'),
                                    feature_group_count=xp.shape[-1])


def gla(q, k, v, log_a, s0):
    bsz, L, H, dk = q.shape
    dv = v.shape[-1]
    c = GLA_CHUNK if L % GLA_CHUNK == 0 else L
    n = L // c
    f32 = jnp.float32
    q = q.astype(f32).reshape(bsz, n, c, H, dk)
    k = k.astype(f32).reshape(bsz, n, c, H, dk)
    v = v.astype(f32).reshape(bsz, n, c, H, dv)
    b = jnp.cumsum(log_a.astype(f32).reshape(bsz, n, c, H, dk), axis=2)
    mask = jnp.tril(jnp.ones((c, c), bool))
    diff = b[:, :, :, None] - b[:, :, None, :]
    decay = jnp.exp(jnp.where(mask[None, None, :, :, None, None], diff, -jnp.inf))
    att = jnp.einsum('bnthd,bnshd,bntshd->bnhts', q, k, decay)
    o_intra = jnp.einsum('bnhts,bnshv->bnthv', att, v)
    b_last = b[:, :, -1]
    ds = jnp.einsum('bnshd,bnshv->bnhdv', k * jnp.exp(b_last[:, :, None] - b), v)

    def step(S, inp):
        dec, dS = inp
        return dec[..., None] * S + dS, S

    s_fin, s_starts = lax.scan(step, s0.astype(f32),
                               (jnp.moveaxis(jnp.exp(b_last), 1, 0), jnp.moveaxis(ds, 1, 0)))
    s_starts = jnp.moveaxis(s_starts, 0, 1)
    o_inter = jnp.einsum('bnthd,bnhdv->bnthv', q * jnp.exp(b), s_starts)
    o = (o_intra + o_inter).reshape(bsz, L, H, dv)
    return o, s_fin.astype(s0.dtype)


def token_mixers(x, hist_a, s0, hist_c, w_in, a_conv_w, b_gate_w2, b_gate_b, b_norm_g,
                 c_conv_w, c_conv_b, c_ln_g, c_ln_b, d_ln_g, d_ln_b, d_ws, d_bs, w_out):
    bsz, L, _ = x.shape
    z = x @ w_in
    z_a, z_q, z_k, z_v, z_g, z_lr, z_c, z_d = jnp.split(z, SPLIT_AT, axis=-1)
    a_b, a_c, a_h = jnp.split(z_a, 3, axis=-1)
    a_full = jnp.concatenate([hist_a.astype(x.dtype), a_c * a_h], axis=1)
    y_a = a_b * causal_dwconv(a_full, a_conv_w)
    new_a = a_full[:, -(K_A - 1):]
    q = z_q.reshape(bsz, L, H_B, DK) * (DK ** -0.5)
    k = z_k.reshape(bsz, L, H_B, DK)
    v = z_v.reshape(bsz, L, H_B, DV)
    log_a = jax.nn.log_sigmoid((z_lr @ b_gate_w2 + b_gate_b).astype(jnp.float32)) / GATE_TAU
    o, new_s = gla(q, k, v, log_a.reshape(bsz, L, H_B, DK), s0)
    o = o * lax.rsqrt(jnp.mean(jnp.square(o), -1, keepdims=True) + LN_EPS)
    y_b = o.reshape(bsz, L, W_B).astype(x.dtype) * b_norm_g * jax.nn.silu(z_g)
    c_a, c_g = jnp.split(z_c, 2, axis=-1)
    c_full = jnp.concatenate([hist_c.astype(x.dtype), c_a * jax.nn.sigmoid(c_g)], axis=1)
    y_c = jax.nn.silu(layer_norm(causal_dwconv(c_full, c_conv_w) + c_conv_b, c_ln_g, c_ln_b))
    new_c = c_full[:, -(K_C - 1):]
    d = jax.nn.gelu(z_d)
    u, vv = d[..., :W_D], d[..., W_D:]
    vv = layer_norm(vv, d_ln_g, d_ln_b)
    c = min(D_CHUNK, L)
    n = L // c
    ws = jnp.tril(d_ws[:, :c, :c])
    vg = vv.reshape(bsz, n, c, H_D, W_D // H_D)
    f = jnp.einsum('gts,bnsgc->bntgc', ws, vg) + d_bs[:, :c].T[None, None, :, :, None]
    y_d = u * f.reshape(bsz, L, W_D)
    y = jnp.concatenate([y_a, y_b, y_c, y_d], axis=-1) @ w_out
    return y, new_a, new_s, new_c, vv


def decoder_layer(x, hist_a, s0, hist_c, p):
    (w_in, a_conv_w, b_gate_w2, b_gate_b, b_norm_g, c_conv_w, c_conv_b, c_ln_g, c_ln_b,
     d_ln_g, d_ln_b, d_ws, d_bs, w_out, ln1_g, ln1_b, w_ff1, w_ff2, ln2_g, ln2_b) = p
    mix, new_a, new_s, new_c, v_rows = token_mixers(
        x, hist_a, s0, hist_c, w_in, a_conv_w, b_gate_w2, b_gate_b, b_norm_g,
        c_conv_w, c_conv_b, c_ln_g, c_ln_b, d_ln_g, d_ln_b, d_ws, d_bs, w_out)
    x = layer_norm(ALPHA * x + mix, ln1_g, ln1_b)
    h = jnp.square(jax.nn.relu(x @ w_ff1)) @ w_ff2
    x = layer_norm(ALPHA * x + h, ln2_g, ln2_b)
    return x, new_a, new_s, new_c, v_rows


def setup_inputs(seed: int = 0) -> dict:
    key = jax.random.key(seed)
    ks = jax.random.split(key, 32)

    def nrm(k, shape, s):
        return jax.random.normal(k, shape, jnp.float32) * s

    return {
        'x_prompt': nrm(ks[0], (BATCH, SEQ, D_MODEL), 1.0),
        'x_sample': nrm(ks[1], (DEC_BATCH, DEC_SEQ, D_MODEL), 1.0),
        'state_conv_a': nrm(ks[2], (DEPTH, DEC_BATCH, K_A - 1, W_A), 1.0),
        'state_gla': nrm(ks[3], (DEPTH, DEC_BATCH, H_B, DK, DV), 0.5),
        'state_conv_c': nrm(ks[4], (DEPTH, DEC_BATCH, K_C - 1, W_C), 0.5),
        'w_in': nrm(ks[5], (DEPTH, D_MODEL, IN_COLS), D_MODEL ** -0.5),
        'a_conv_w': nrm(ks[6], (DEPTH, K_A, W_A), K_A ** -0.5),
        'b_gate_w2': nrm(ks[7], (DEPTH, GATE_RANK, H_B * DK), GATE_RANK ** -0.5),
        'b_gate_b': nrm(ks[8], (DEPTH, H_B * DK), 0.01),
        'b_norm_g': 1.0 + nrm(ks[9], (DEPTH, W_B), 0.01),
        'c_conv_w': nrm(ks[10], (DEPTH, K_C, W_C), K_C ** -0.5),
        'c_conv_b': nrm(ks[11], (DEPTH, W_C), 0.01),
        'c_ln_g': 1.0 + nrm(ks[12], (DEPTH, W_C), 0.01),
        'c_ln_b': nrm(ks[13], (DEPTH, W_C), 0.01),
        'd_ln_g': 1.0 + nrm(ks[14], (DEPTH, W_D), 0.01),
        'd_ln_b': nrm(ks[15], (DEPTH, W_D), 0.01),
        'd_ws': nrm(ks[16], (DEPTH, H_D, D_CHUNK, D_CHUNK), D_CHUNK ** -0.5),
        'd_bs': 1.0 + nrm(ks[17], (DEPTH, H_D, D_CHUNK), 0.01),
        'w_out': nrm(ks[18], (DEPTH, MIX, D_MODEL), BETA * MIX ** -0.5),
        'ln1_g': 1.0 + nrm(ks[19], (DEPTH, D_MODEL), 0.01),
        'ln1_b': nrm(ks[20], (DEPTH, D_MODEL), 0.01),
        'w_ff1': nrm(ks[21], (DEPTH, D_MODEL, D_FF), D_MODEL ** -0.5),
        'w_ff2': nrm(ks[22], (DEPTH, D_FF, D_MODEL), BETA * D_FF ** -0.5),
        'ln2_g': 1.0 + nrm(ks[23], (DEPTH, D_MODEL), 0.01),
        'ln2_b': nrm(ks[24], (DEPTH, D_MODEL), 0.01),
    }


def reference(x_prompt, x_sample, state_conv_a, state_gla, state_conv_c, w_in, a_conv_w,
              b_gate_w2, b_gate_b, b_norm_g, c_conv_w, c_conv_b, c_ln_g, c_ln_b, d_ln_g, d_ln_b,
              d_ws, d_bs, w_out, ln1_g, ln1_b, w_ff1, w_ff2, ln2_g, ln2_b):
    weights = (w_in, a_conv_w, b_gate_w2, b_gate_b, b_norm_g, c_conv_w, c_conv_b, c_ln_g, c_ln_b,
               d_ln_g, d_ln_b, d_ws, d_bs, w_out, ln1_g, ln1_b, w_ff1, w_ff2, ln2_g, ln2_b)
    bp = x_prompt.shape[0]
    xp, xs = x_prompt, x_sample
    pa, ps, pc = [], [], []
    sa, ss, sc, sv = [], [], [], []
    for l in range(DEPTH):
        p = tuple(w[l] for w in weights)
        xp, na, ns, nc, _ = decoder_layer(
            xp, jnp.zeros((bp, K_A - 1, W_A), xp.dtype),
            jnp.zeros((bp, H_B, DK, DV), state_gla.dtype),
            jnp.zeros((bp, K_C - 1, W_C), xp.dtype), p)
        pa.append(na); ps.append(ns); pc.append(nc)
        xs, na, ns, nc, nv = decoder_layer(xs, state_conv_a[l], state_gla[l], state_conv_c[l], p)
        sa.append(na); ss.append(ns); sc.append(nc); sv.append(nv)
    return (xp, xs, jnp.stack(pa), jnp.stack(sa), jnp.stack(ps), jnp.stack(ss),
            jnp.stack(pc), jnp.stack(sc), jnp.stack(sv))
```

```cpp
#include <hip/hip_runtime.h>
#include <cstdio>
#include <cstdint>
namespace pg8 {
#define PG8_LAS __attribute__((address_space(3)))
typedef unsigned short bf16_t;
typedef short bf16x8 __attribute__((ext_vector_type(8)));
typedef float f32x4 __attribute__((ext_vector_type(4)));
typedef unsigned u32x4 __attribute__((ext_vector_type(4)));
constexpr int BM = 256, BK = 64, HALF = 128, HTB = HALF * BK * 2  , STAGE_BYTES = 8 * HTB, NXCD = 8, WGM = 8;

__host__ __device__ __forceinline__ int lds_byte(int r, int c) { const int st = (r >> 4) * 2 + (c >> 5), rr = r & 15, cc = c & 31, ob = rr * 64 + cc * 2; return st * 1024 + (ob ^ (((ob >> 9) & 1) << 5)); }
__host__ __device__ __forceinline__ void stage_rc(int b, int& R, int& C) { const int st = b / 1024, sb = b % 1024, swz = sb ^ (((sb >> 9) & 1) << 5); R = (st >> 1) * 16 + swz / 64; C = (st & 1) * 32 + (swz % 64) / 2; }
__host__ __device__ __forceinline__ int perm32(int rho) { const int n = rho >> 4, i = rho & 15; return 8 * (i >> 2) + 4 * n + (i & 3); }

struct Unit { int pm, pn; };
struct Gemm { const bf16_t* A; const bf16_t* Bt; int M, N, K; };

struct StaticOrder {
    int nM, nN, nwg, G, c;
    __host__ __device__ void init(int M, int N, int G_, int c_) { nM = M / BM; nN = N / BM; nwg = nM * nN; G = G_; c = c_; }
    __host__ __device__ bool next(int i, Unit& u) const {
        const long L = (long)i * G + c; if (L >= nwg) return false;
        int wgid = (int)L; { const int q = nwg / NXCD, r = nwg % NXCD, xcd = wgid % NXCD, off = wgid / NXCD; wgid = (xcd < r ? xcd * (q + 1) : r * (q + 1) + (xcd - r) * q) + off; }
        const int nig = WGM * nN, gid = wgid / nig, fm = gid * WGM, gsz = (nM - fm) < WGM ? (nM - fm) : WGM;
        u.pm = fm + ((wgid % nig) % gsz); u.pn = (wgid % nig) / gsz; return true;
    }
    __device__ __forceinline__ void a_ready(const Unit&) const {}
    __device__ __forceinline__ void done(const Unit&) const {}
};


__device__ __forceinline__ unsigned cvt_pk_bf16(float lo, float hi) { unsigned r; asm volatile("v_cvt_pk_bf16_f32 %0, %1, %2" : "=v"(r) : "v"(lo), "v"(hi)); return r; }

template <int ACT> struct EpiBf16 {
    static constexpr bool PERM = true, AFTER_DRAIN = false;
    bf16_t* O; int ldc;
    __device__ __forceinline__ void operator()(const f32x4 (&acc)[2][2][4][2], const Unit& u, int wr, int wc, int fr, int fq) const {
        const int row0 = u.pm * BM + wr * 64 + fr; const int col0 = u.pn * BM + wc * 32 + 8 * fq;
#pragma unroll
        for (int ai = 0; ai < 2; ++ai)
#pragma unroll
            for (int m = 0; m < 4; ++m) { bf16_t* rowp = O + (size_t)(row0 + ai * HALF + m * 16) * ldc + col0;
#pragma unroll
                for (int bj = 0; bj < 2; ++bj) { f32x4 v0 = acc[ai][bj][m][0], v1 = acc[ai][bj][m][1];
                    if (ACT == 2) {
#pragma unroll
                        for (int e = 0; e < 4; ++e) { const float a = fmaxf(v0[e], 0.f), b = fmaxf(v1[e], 0.f); v0[e] = a * a; v1[e] = b * b; } }
                    u32x4 w; w.x = cvt_pk_bf16(v0[0], v0[1]); w.y = cvt_pk_bf16(v0[2], v0[3]); w.z = cvt_pk_bf16(v1[0], v1[1]); w.w = cvt_pk_bf16(v1[2], v1[3]);
                    *(u32x4*)(rowp + bj * HALF) = w; } }
    }
};

struct EpiRes {
    static constexpr bool PERM = false, AFTER_DRAIN = false;
    const float* resA; const float* resB; int split; float* out; int ldc; float alpha;
    __device__ __forceinline__ void operator()(const f32x4 (&acc)[2][2][4][2], const Unit& u, int wr, int wc, int fr, int fq) const {
        const int row0 = u.pm * BM + wr * 64 + fr, col0 = u.pn * BM + wc * 32 + 4 * fq;
        const float* rb = (u.pm * BM < split) ? resA : (resB - (size_t)split * ldc);
#pragma unroll
        for (int ai = 0; ai < 2; ++ai)
#pragma unroll
            for (int m = 0; m < 4; ++m) { const size_t off = (size_t)(row0 + ai * HALF + m * 16) * ldc + col0;
#pragma unroll
                for (int bj = 0; bj < 2; ++bj)
#pragma unroll
                    for (int n = 0; n < 2; ++n) { const f32x4 r = *(const f32x4*)(rb + off + bj * HALF + n * 16); *(f32x4*)(out + off + bj * HALF + n * 16) = r * alpha + acc[ai][bj][m][n]; } }
    }
};

template <class Epi, class Sched, bool ALIGN_EPI = false, bool SP2 = false>
__device__ __forceinline__ void gemm_phase(PG8_LAS unsigned char* lds, const Gemm g, const Sched& S, const Epi& E) {
    const int tid = threadIdx.x, wid = __builtin_amdgcn_readfirstlane(tid >> 6), lane = tid & 63, wr = wid >> 2, wc = wid & 3, fr = lane & 15, fq = lane >> 4;
    const int K = g.K, nt = K / BK;
    unsigned voffA[2], voffB[2];
#pragma unroll
    for (int i = 0; i < 2; ++i) { int R, C; stage_rc(tid * 16 + i * 8192, R, C); const int Rb = Epi::PERM ? ((R & ~31) + perm32(R & 31)) : R;
        voffA[i] = (unsigned)(R * K + C) * 2u; voffB[i] = (unsigned)(Rb * K + C) * 2u; }
    const size_t kstep = (size_t)(BK * 2);
    const size_t hstep = (size_t)HALF * K * 2;
    const size_t tstep = 2 * hstep;
    const unsigned ldsw = (unsigned)wid * 1024u;
    const int aoff = lds_byte(wr * 64 + fr, fq * 8), boff = lds_byte(wc * 32 + fr, fq * 8);
#define PG8_SA(b, h) (((b) * 2 + (h)) * HTB)
#define PG8_SB(b, h) ((4 + (b) * 2 + (h)) * HTB)
#define PG8_STAGE(bufoff, gbase, voff) do { _Pragma("unroll") for (int _i = 0; _i < 2; ++_i) \
        __builtin_amdgcn_global_load_lds((const unsigned*)((const char*)(gbase) + (voff)[_i]), (PG8_LAS unsigned*)(lds + (bufoff) + ldsw + _i * 8192), 16, 0, 0); } while (0)
#define PG8_LDA(dst, b, h) do { _Pragma("unroll") for (int m = 0; m < 4; ++m) _Pragma("unroll") for (int k = 0; k < 2; ++k) dst[m][k] = *(const PG8_LAS bf16x8*)(lds + PG8_SA(b, h) + aoff + m * 2048 + k * 1024); } while (0)
#define PG8_LDB(dst, b, h) do { _Pragma("unroll") for (int n = 0; n < 2; ++n) _Pragma("unroll") for (int k = 0; k < 2; ++k) dst[n][k] = *(const PG8_LAS bf16x8*)(lds + PG8_SB(b, h) + boff + n * 2048 + k * 1024); } while (0)
#define PG8_MMA(ai, bj, At, Bt) do { __builtin_amdgcn_s_setprio(1); _Pragma("unroll") for (int m = 0; m < 4; ++m) _Pragma("unroll") for (int n = 0; n < 2; ++n) _Pragma("unroll") for (int k = 0; k < 2; ++k) \
        acc[ai][bj][m][n] = __builtin_amdgcn_mfma_f32_16x16x32_bf16(Bt[n][k], At[m][k], acc[ai][bj][m][n], 0, 0, 0); __builtin_amdgcn_s_setprio(0); } while (0)
#define PG8_WAIT_V(n) asm volatile("s_waitcnt vmcnt(" #n ")" ::: "memory")
#define PG8_WAIT_L(n) asm volatile("s_waitcnt lgkmcnt(" #n ")" ::: "memory")
#define PG8_BAR __builtin_amdgcn_s_barrier()
#define PG8_SCHED __builtin_amdgcn_sched_barrier(0)
    Unit cur, nxt; int ui = 0;
    if (!S.next(0, cur)) return;
    f32x4 acc[2][2][4][2];
#pragma unroll
    for (int a = 0; a < 2; ++a)
#pragma unroll
        for (int b = 0; b < 2; ++b)
#pragma unroll
            for (int m = 0; m < 4; ++m)
#pragma unroll
                for (int n = 0; n < 2; ++n) acc[a][b][m][n] = (f32x4){0.f, 0.f, 0.f, 0.f};
    bf16x8 At[4][2], B0[2][2], B1[2][2];
    const char* cA = (const char*)g.A + (size_t)cur.pm * tstep; const char* cB = (const char*)g.Bt + (size_t)cur.pn * tstep;
    S.a_ready(cur);
    if constexpr (SP2) {
        PG8_STAGE(PG8_SB(0, 0), cB, voffB); PG8_STAGE(PG8_SB(0, 1), cB + hstep, voffB); PG8_STAGE(PG8_SA(0, 0), cA, voffA); PG8_STAGE(PG8_SA(0, 1), cA + hstep, voffA);
        if (wr == 1) PG8_BAR;
        PG8_WAIT_V(2); PG8_BAR;
        PG8_STAGE(PG8_SB(1, 0), cB + kstep, voffB); PG8_STAGE(PG8_SA(1, 0), cA + kstep, voffA); PG8_STAGE(PG8_SB(1, 1), cB + hstep + kstep, voffB);
        PG8_WAIT_V(6); PG8_BAR;
    } else {
        PG8_STAGE(PG8_SB(0, 0), cB, voffB); PG8_STAGE(PG8_SA(0, 0), cA, voffA); PG8_STAGE(PG8_SB(0, 1), cB + hstep, voffB); PG8_STAGE(PG8_SA(0, 1), cA + hstep, voffA);
        if (wr == 1) PG8_BAR;
        PG8_WAIT_V(4); PG8_BAR;
        PG8_STAGE(PG8_SB(1, 0), cB + kstep, voffB); PG8_STAGE(PG8_SA(1, 0), cA + kstep, voffA); PG8_STAGE(PG8_SB(1, 1), cB + hstep + kstep, voffB);
        PG8_WAIT_V(6); PG8_BAR;
    }
    for (;;) {
        const bool has_next = S.next(ui + 1, nxt);
        const char* nA = has_next ? (const char*)g.A + (size_t)nxt.pm * tstep : cA; const char* nB = has_next ? (const char*)g.Bt + (size_t)nxt.pn * tstep : cB;
        for (int t = 0; t < nt; t += 2) {
            const bool last = (t == nt - 2);
            const char* a1 = cA + (size_t)(t + 1) * kstep;
            const char* a2 = last ? nA : cA + (size_t)(t + 2) * kstep; const char* b2 = last ? nB : cB + (size_t)(t + 2) * kstep;
            const char* a3 = a2 + kstep; const char* b3 = b2 + kstep;
            if (last && has_next) S.a_ready(nxt);
            if constexpr (SP2) {
            PG8_LDB(B0, 0, 0); PG8_LDB(B1, 0, 1); PG8_SCHED; PG8_LDA(At, 0, 0); PG8_STAGE(PG8_SA(1, 1), a1 + hstep, voffA);
            PG8_WAIT_V(8); PG8_WAIT_L(0); PG8_BAR; PG8_MMA(0, 0, At, B0); PG8_MMA(0, 1, At, B1); PG8_BAR; PG8_SCHED;
            PG8_LDA(At, 0, 1); PG8_STAGE(PG8_SB(0, 0), b2, voffB); PG8_STAGE(PG8_SB(0, 1), b2 + hstep, voffB); PG8_STAGE(PG8_SA(0, 0), a2, voffA);
            PG8_WAIT_V(8); PG8_WAIT_L(0); PG8_BAR; PG8_MMA(1, 0, At, B0); PG8_MMA(1, 1, At, B1); PG8_BAR; PG8_SCHED;
            PG8_LDB(B0, 1, 0); PG8_LDB(B1, 1, 1); PG8_SCHED; PG8_LDA(At, 1, 0); PG8_STAGE(PG8_SA(0, 1), a2 + hstep, voffA);
            PG8_WAIT_V(8); PG8_WAIT_L(0); PG8_BAR; PG8_MMA(0, 0, At, B0); PG8_MMA(0, 1, At, B1); PG8_BAR; PG8_SCHED;
            PG8_LDA(At, 1, 1); PG8_STAGE(PG8_SB(1, 0), b3, voffB); PG8_STAGE(PG8_SB(1, 1), b3 + hstep, voffB); PG8_STAGE(PG8_SA(1, 0), a3, voffA);
            PG8_WAIT_V(8); PG8_WAIT_L(0); PG8_BAR; PG8_MMA(1, 0, At, B0); PG8_MMA(1, 1, At, B1); PG8_BAR; PG8_SCHED;
            } else {
            PG8_LDB(B0, 0, 0); PG8_SCHED; PG8_LDA(At, 0, 0); PG8_STAGE(PG8_SA(1, 1), a1 + hstep, voffA);
            PG8_WAIT_L(8); PG8_BAR; PG8_WAIT_L(0); PG8_MMA(0, 0, At, B0); PG8_BAR; PG8_SCHED;
            PG8_LDB(B1, 0, 1); PG8_STAGE(PG8_SB(0, 0), b2, voffB);
            PG8_BAR; PG8_WAIT_L(0); PG8_MMA(0, 1, At, B1); PG8_BAR;
            PG8_LDA(At, 0, 1); PG8_STAGE(PG8_SA(0, 0), a2, voffA);
            PG8_BAR; PG8_WAIT_L(0); PG8_MMA(1, 0, At, B0); PG8_BAR; PG8_SCHED;
            PG8_STAGE(PG8_SB(0, 1), b2 + hstep, voffB);
            PG8_WAIT_V(6); PG8_BAR; PG8_MMA(1, 1, At, B1); PG8_BAR;
            PG8_LDB(B0, 1, 0); PG8_SCHED; PG8_LDA(At, 1, 0); PG8_STAGE(PG8_SA(0, 1), a2 + hstep, voffA);
            PG8_WAIT_L(8); PG8_BAR; PG8_WAIT_L(0); PG8_MMA(0, 0, At, B0); PG8_BAR; PG8_SCHED;
            PG8_LDB(B1, 1, 1); PG8_STAGE(PG8_SB(1, 0), b3, voffB);
            PG8_BAR; PG8_WAIT_L(0); PG8_MMA(0, 1, At, B1); PG8_BAR;
            PG8_LDA(At, 1, 1); PG8_STAGE(PG8_SA(1, 0), a3, voffA);
            PG8_BAR; PG8_WAIT_L(0); PG8_MMA(1, 0, At, B0); PG8_BAR; PG8_SCHED;
            PG8_STAGE(PG8_SB(1, 1), b3 + hstep, voffB);
            PG8_WAIT_V(6); PG8_BAR; PG8_MMA(1, 1, At, B1); PG8_BAR;
            }
        }
        if constexpr (ALIGN_EPI) { if (wr == 0) PG8_BAR; }
        if constexpr (!Epi::AFTER_DRAIN) { E(acc, cur, wr, wc, fr, fq); S.done(cur); }
        if (!has_next) break;
#pragma unroll
        for (int a = 0; a < 2; ++a)
#pragma unroll
            for (int b = 0; b < 2; ++b)
#pragma unroll
                for (int m = 0; m < 4; ++m)
#pragma unroll
                    for (int n = 0; n < 2; ++n) acc[a][b][m][n] = (f32x4){0.f, 0.f, 0.f, 0.f};
        cur = nxt; cA = nA; cB = nB; ++ui;
        if constexpr (ALIGN_EPI) { if (wr == 1) PG8_BAR; }
    }
    PG8_WAIT_V(0);
    if constexpr (!ALIGN_EPI) { if (wr == 0) PG8_BAR; }
    PG8_BAR;
    if constexpr (Epi::AFTER_DRAIN) { E.fused(acc, cur, wr, wc, fr, fq, lds, wid, lane); S.done(cur); }
#undef PG8_SA
#undef PG8_SB
#undef PG8_STAGE
#undef PG8_LDA
#undef PG8_LDB
#undef PG8_MMA
#undef PG8_WAIT_V
#undef PG8_WAIT_L
#undef PG8_BAR
#undef PG8_SCHED
}
}

constexpr int NWAVES = 8;
#ifndef MK_N_LAUNCHES
#define MK_N_LAUNCHES 1
#endif

constexpr int D = 1024, NB = 8, SEQ = 2048, DEPTH = 2, DB = 128, DSEQ = 8, FF = 4096;
constexpr int MP = NB * SEQ, MS = DB * DSEQ, M = MP + MS;
constexpr int INC = 2576, NZ = 2816;
constexpr int ZC_AB = 0, ZC_AC = 256, ZC_AH = 512, ZC_Q = 768, ZC_K = 896, ZC_V = 1024, ZC_G = 1280, ZC_CA = 1536, ZC_CG = 1792, ZC_U = 2048, ZC_VV = 2304, ZC_LR = 2560;
constexpr float LN_EPS = 1e-5f;
constexpr float ALPHA = 1.41421356237309515f;
constexpr size_t O_Y = 0, O_CAP = (size_t)M * D, O_CAS = O_CAP + 2 * 8 * 2 * 256, O_GP = O_CAS + 2 * 128 * 2 * 256, O_GS = O_GP + 2 * 8 * 4 * 32 * 64,
                 O_CCP = O_GS + (size_t)2 * 128 * 4 * 32 * 64, O_CCS = O_CCP + 2 * 8 * 30 * 256, O_CV = O_CCS + (size_t)2 * 128 * 30 * 256, O_END = O_CV + (size_t)2 * 128 * 8 * 256;

constexpr size_t MiB = 1u << 20;
constexpr size_t WS_CTL = 0, CTL_ZERO_BYTES = 1 * MiB;
constexpr size_t WS_W = 1 * MiB;
constexpr size_t W_IN_OFF = 0, W_OUT_OFF = (size_t)NZ * D * 2, W_FF1_OFF = W_OUT_OFF + (size_t)D * D * 2, W_FF2_OFF = W_FF1_OFF + (size_t)FF * D * 2, W_LAYER = W_FF2_OFF + (size_t)D * FF * 2;
static_assert(W_LAYER == 24641536, "23.5 MiB per layer");
constexpr size_t WS_XNA = 48 * MiB, WS_XNB = 82 * MiB;
constexpr size_t WS_R = 116 * MiB;
constexpr size_t WS_Z = WS_R, WS_Y = WS_R + (size_t)M * NZ * 2, WS_H = WS_R;
constexpr size_t WS_END = 256 * MiB;
static_assert(WS_W + 2 * W_LAYER <= WS_XNA && WS_Y + (size_t)M * D * 2 <= 252 * MiB && WS_H + (size_t)M * FF * 2 == 252 * MiB, "d_ws map");
constexpr size_t WS_VV = WS_XNB, WS_SUMS = WS_VV + (size_t)M * 256 * 4, WS_SUMP = WS_SUMS + (size_t)1024 * 2048 * 4;
static_assert(WS_SUMP + 1024 * 32 * 4 <= WS_R, "mixer scratch inside XNB");
constexpr int CW_TMO = 0, CW_BAR = 4096;

constexpr int RING_OFF = 0, RING_BYTES = 131072;
constexpr int LDSCTL_OFF = RING_BYTES, MISC_OFF = LDSCTL_OFF + 320;
constexpr int LDS_BYTES = 147456;

#define GAS __attribute__((address_space(1)))
#define LAS __attribute__((address_space(3)))
typedef unsigned short bf16;
typedef unsigned v4u __attribute__((ext_vector_type(4)));
typedef unsigned v2u __attribute__((ext_vector_type(2)));
typedef float f32x4 __attribute__((ext_vector_type(4)));
typedef GAS unsigned gu32;
#define RLX_AGENT __ATOMIC_RELAXED, __HIP_MEMORY_SCOPE_AGENT
#define LDS_WAIT() asm volatile("s_waitcnt lgkmcnt(0)" ::: "memory")
#define VM_WAIT() asm volatile("s_waitcnt vmcnt(0)" ::: "memory")
__device__ __forceinline__ unsigned f2bf(float f) { unsigned u = __builtin_bit_cast(unsigned, f); return (u + 0x7fffu + ((u >> 16) & 1u)) >> 16; }
__device__ __forceinline__ unsigned pk2(float lo, float hi) { return f2bf(lo) | (f2bf(hi) << 16); }
__device__ __forceinline__ float bflo(unsigned w) { return __uint_as_float(w << 16); }
__device__ __forceinline__ float bfhi(unsigned w) { return __uint_as_float(w & 0xffff0000u); }
__device__ __forceinline__ float bf1(bf16 h) { return __uint_as_float((unsigned)h << 16); }
__device__ __forceinline__ f32x4 ld_bf4(const bf16* p) { const v2u w = *(const v2u*)p; return (f32x4){bflo(w.x), bfhi(w.x), bflo(w.y), bfhi(w.y)}; }
__device__ __forceinline__ void st_bf4(bf16* p, f32x4 v) { v2u w; w.x = pk2(v[0], v[1]); w.y = pk2(v[2], v[3]); *(v2u*)p = w; }
__device__ __forceinline__ float sigmoidf_(float x) { return 1.f / (1.f + __expf(-x)); }
__device__ __forceinline__ float siluf_(float x) { return x * sigmoidf_(x); }
__device__ __forceinline__ float gelu_tanh(float x) { const float u = 0.7978845608028654f * (x + 0.044715f * x * x * x); const float t = 1.f - 2.f / (1.f + __expf(2.f * u)); return 0.5f * x * (1.f + t); }
__device__ __forceinline__ float wave_sum(float v) {
#pragma unroll
    for (int o = 1; o < 64; o <<= 1) v += __shfl_xor(v, o);
    return v;
}

#define XB_TMO      128
#define XB_XCNT(j)  (256  + 64 * (j))
#define XB_XSUB(j)  (1280 + 64 * (j))
#define XB_XGEN(j)  (2304 + 64 * (j))
#define XB_TOP      3328
#define XB_TOPGEN   3392
#define XCD_BAR_WORDS 3456
#define XB_SPIN_CAP (1u << 18)
__device__ __forceinline__ unsigned xb_ld(unsigned* p)              { return __hip_atomic_load(p, __ATOMIC_RELAXED, __HIP_MEMORY_SCOPE_AGENT); }
__device__ __forceinline__ unsigned xb_add(unsigned* p, unsigned v) { return __hip_atomic_fetch_add(p, v, __ATOMIC_RELAXED, __HIP_MEMORY_SCOPE_AGENT); }
__device__ __forceinline__ unsigned xb_xcc_id() { return (unsigned)__builtin_amdgcn_s_getreg((3 << 11) | 20) & 0xFu; }
#define XB_SPIN(cond, bar) do { unsigned _sp = 0; while (cond) { __builtin_amdgcn_s_sleep(1); \
    if ((++_sp & 255u) == 0u) { if (xb_ld(&(bar)[XB_TMO])) break; if (_sp > XB_SPIN_CAP) { atomicAdd(&(bar)[XB_TMO], 1u); break; } } } } while (0)
struct XcdBarrier { unsigned* bar; unsigned x; volatile LAS unsigned* st; };
__device__ __forceinline__ XcdBarrier xcd_barrier_post(unsigned* bar, volatile LAS unsigned* st) {
    XcdBarrier b; b.bar = bar; b.x = xb_xcc_id(); b.st = st;
    if (threadIdx.x == 0) (void)xb_add(&bar[XB_XCNT(b.x)], 1u);
    return b;
}
__device__ __forceinline__ void xcd_barrier_complete(unsigned* bar, unsigned x, unsigned& nloc, unsigned& nx) {
    const unsigned G = gridDim.x * gridDim.y * gridDim.z;
    unsigned sum, cnt, mine, sp = 0u;
    for (;;) {
        sum = 0u; cnt = 0u; mine = 0u;
#pragma unroll
        for (unsigned j = 0; j < 16; ++j) { const unsigned c = xb_ld(&bar[XB_XCNT(j)]); sum += c; cnt += (c > 0u) ? 1u : 0u; mine = (j == x) ? c : mine; }
        if (sum == G) break;
        __builtin_amdgcn_s_sleep(1);
        if ((++sp & 255u) == 0u) { if (xb_ld(&bar[XB_TMO])) break; if (sp > XB_SPIN_CAP) { atomicAdd(&bar[XB_TMO], 1u); break; } }
    }
    nloc = mine > 0u ? mine : 1u; nx = cnt > 0u ? cnt : 1u;
}
__device__ __forceinline__ void xcd_barrier(const XcdBarrier& b) {
    asm volatile("s_waitcnt vmcnt(0)" ::: "memory");
    __syncthreads();
    if (threadIdx.x == 0) {
        unsigned* bar = b.bar;
        __builtin_amdgcn_s_waitcnt(0);
        unsigned nloc = b.st[0], nx = b.st[1];
        if (nloc == 0u) { xcd_barrier_complete(bar, b.x, nloc, nx); b.st[0] = nloc; b.st[1] = nx; }
        const unsigned old = xb_add(&bar[XB_XSUB(b.x)], 1u);
        const unsigned gen = old / nloc;
        if (old + 1u == (gen + 1u) * nloc) {
            __builtin_amdgcn_fence(__ATOMIC_RELEASE, "agent");
            asm volatile("s_waitcnt vmcnt(0)" ::: "memory");
            const unsigned og = xb_add(&bar[XB_TOP], 1u);
            const unsigned tg = og / nx;
            if (og + 1u == (tg + 1u) * nx) xb_add(&bar[XB_TOPGEN], 1u);
            else XB_SPIN(xb_ld(&bar[XB_TOPGEN]) == tg, bar);
            __builtin_amdgcn_fence(__ATOMIC_ACQUIRE, "agent");
            xb_add(&bar[XB_XGEN(b.x)], 1u);
            asm volatile("s_waitcnt vmcnt(0)" ::: "memory");
        } else {
            XB_SPIN(xb_ld(&bar[XB_XGEN(b.x)]) == gen, bar);
            __builtin_amdgcn_fence(__ATOMIC_ACQUIRE, "agent");
            asm volatile("s_waitcnt vmcnt(0)" ::: "memory");
        }
    }
    __syncthreads();
}

struct Args { const float* in[25]; float* out; unsigned char* ws; int ph_lo, ph_hi; };
struct Frame {
    LAS unsigned char* lds;
    volatile LAS unsigned* MISC;
    int tid, lane, wave, vcu, G;
    const float* const* in;
    float* out; unsigned char* ws;
};
#define IN_XP 0
#define IN_XS 1
#define IN_SCA 2
#define IN_SGLA 3
#define IN_SCC 4
#define IN_WIN 5
#define IN_ACW 6
#define IN_GW2 7
#define IN_GB 8
#define IN_BNG 9
#define IN_CCW 10
#define IN_CCB 11
#define IN_CLG 12
#define IN_CLB 13
#define IN_DLG 14
#define IN_DLB 15
#define IN_DWS 16
#define IN_DBS 17
#define IN_WOUT 18
#define IN_L1G 19
#define IN_L1B 20
#define IN_FF1 21
#define IN_FF2 22
#define IN_L2G 23
#define IN_L2B 24

__device__ __forceinline__ int zmap(int c) { return c < 1536 ? c : (c < 2560 ? c + 16 : (c < 2576 ? c - 1024 : -1)); }
template <bool MAPIN>
__device__ __forceinline__ void p0_transpose_item(const float* W, int K, int Nsrc, int Ndst, bf16* WT, LAS float* scr, int item, int lane) {
    const int nblk = Ndst / 32, kb = item / nblk, nb = item % nblk, k0 = 64 * kb, n0 = 32 * nb;
    int sc = n0 + (lane & 31); if (MAPIN) sc = zmap(sc);
#pragma unroll 8
    for (int i = 0; i < 32; ++i) { const int kk = 2 * i + (lane >> 5); scr[kk * 33 + (lane & 31)] = (sc >= 0) ? W[(size_t)(k0 + kk) * Nsrc + sc] : 0.f; }
    LDS_WAIT(); asm volatile("" ::: "memory");
    const int c = lane & 7;
#pragma unroll
    for (int j = 0; j < 4; ++j) { const int n = (lane >> 3) + 8 * j; const LAS float* s = scr + (8 * c) * 33 + n;
        v4u o; o.x = pk2(s[0 * 33], s[1 * 33]); o.y = pk2(s[2 * 33], s[3 * 33]); o.z = pk2(s[4 * 33], s[5 * 33]); o.w = pk2(s[6 * 33], s[7 * 33]);
        *(GAS v4u*)(WT + (size_t)(n0 + n) * K + k0 + 8 * c) = o; }
    LDS_WAIT(); asm volatile("" ::: "memory");
}
__device__ __forceinline__ void p0_prologue(Frame& F) {
    LAS float* scr = (LAS float*)(F.lds + RING_OFF + F.wave * 16384);
    const int gw = F.vcu * NWAVES + F.wave, NGW = F.G * NWAVES;
    constexpr int I_IN = (D / 64) * (NZ / 32), I_O = (D / 64) * (D / 32), I_1 = (D / 64) * (FF / 32), I_2 = (FF / 64) * (D / 32), I_L = I_IN + I_O + I_1 + I_2;
    for (int it = gw; it < 2 * I_L; it += NGW) {
        const int l = it / I_L; int r = it % I_L;
        unsigned char* wl = F.ws + WS_W + (size_t)l * W_LAYER;
        if (r < I_IN) { p0_transpose_item<true>(F.in[IN_WIN] + (size_t)l * D * INC, D, INC, NZ, (bf16*)(wl + W_IN_OFF), scr, r, F.lane); continue; } r -= I_IN;
        if (r < I_O) { p0_transpose_item<false>(F.in[IN_WOUT] + (size_t)l * D * D, D, D, D, (bf16*)(wl + W_OUT_OFF), scr, r, F.lane); continue; } r -= I_O;
        if (r < I_1) { p0_transpose_item<false>(F.in[IN_FF1] + (size_t)l * D * FF, D, FF, FF, (bf16*)(wl + W_FF1_OFF), scr, r, F.lane); continue; } r -= I_1;
        p0_transpose_item<false>(F.in[IN_FF2] + (size_t)l * FF * D, FF, D, D, (bf16*)(wl + W_FF2_OFF), scr, r, F.lane);
    }
    bf16* XA = (bf16*)(F.ws + WS_XNA);
    for (int m = gw; m < M; m += NGW) {
        const float* xr = (m < MP) ? F.in[IN_XP] + (size_t)m * D : F.in[IN_XS] + (size_t)(m - MP) * D;
#pragma unroll
        for (int j = 0; j < 4; ++j) { const f32x4 v = *(const f32x4*)(xr + 4 * F.lane + 256 * j); st_bf4(XA + (size_t)m * D + 4 * F.lane + 256 * j, v); }
    }
}

template <bool WF32>
__device__ __forceinline__ void ln_phase(Frame& F, float* v, const float* g, const float* bta, bf16* xn) {
    const int gw = F.vcu * NWAVES + F.wave, NGW = F.G * NWAVES;
    for (int m = gw; m < M; m += NGW) {
        float* row = v + (size_t)m * D + 4 * F.lane;
        f32x4 x[4]; float s = 0.f;
#pragma unroll
        for (int j = 0; j < 4; ++j) { x[j] = *(const f32x4*)(row + 256 * j); s += (x[j][0] + x[j][1]) + (x[j][2] + x[j][3]); }
        const float mean = wave_sum(s) * (1.f / D); float s2 = 0.f;
#pragma unroll
        for (int j = 0; j < 4; ++j) { x[j] = x[j] - mean; s2 += (x[j][0] * x[j][0] + x[j][1] * x[j][1]) + (x[j][2] * x[j][2] + x[j][3] * x[j][3]); }
        const float rstd = 1.f / sqrtf(wave_sum(s2) * (1.f / D) + LN_EPS);
#pragma unroll
        for (int j = 0; j < 4; ++j) { const f32x4 gg = *(const f32x4*)(g + 4 * F.lane + 256 * j), bb = *(const f32x4*)(bta + 4 * F.lane + 256 * j);
            const f32x4 o = x[j] * rstd * gg + bb;
            if (WF32) *(f32x4*)(row + 256 * j) = o;
            st_bf4(xn + (size_t)m * D + 4 * F.lane + 256 * j, o); }
    }
}

__device__ __forceinline__ void vv_row(Frame& F, int l, int m) {
    const bf16* Z = (const bf16*)(F.ws + WS_Z); float* VV = (float*)(F.ws + WS_VV);
    const int ch = 4 * F.lane;
    f32x4 z = ld_bf4(Z + (size_t)m * NZ + ZC_VV + ch);
#pragma unroll
    for (int e = 0; e < 4; ++e) z[e] = gelu_tanh(z[e]);
    const float mean = wave_sum((z[0] + z[1]) + (z[2] + z[3])) * (1.f / 256.f);
    z = z - mean;
    const float var = wave_sum((z[0] * z[0] + z[1] * z[1]) + (z[2] * z[2] + z[3] * z[3])) * (1.f / 256.f);
    const float rstd = 1.f / sqrtf(var + LN_EPS);
    const f32x4 g = *(const f32x4*)(F.in[IN_DLG] + l * 256 + ch), b = *(const f32x4*)(F.in[IN_DLB] + l * 256 + ch);
    const f32x4 o = z * rstd * g + b;
    *(f32x4*)(VV + (size_t)m * 256 + ch) = o;
    if (m >= MP) *(f32x4*)(F.out + O_CV + ((size_t)l * MS + (m - MP)) * 256 + ch) = o;
}

__device__ __forceinline__ float log_sigmoid_(float x) { return fminf(x, 0.f) - log1pf(__expf(-fabsf(x))); }
template <bool PASS2>
__device__ __forceinline__ void gla_task(Frame& F, int l, int task, LAS float* stg) {
    const bf16* Z = (const bf16*)(F.ws + WS_Z); bf16* Y = (bf16*)(F.ws + WS_Y);
    float* SUMS = (float*)(F.ws + WS_SUMS); float* SUMP = (float*)(F.ws + WS_SUMP);
    const int lane = F.lane, h = task & 3, d = lane & 31, tt0 = lane >> 5;
    const bool samp = task >= 1024;
    const int b = task >> 7, j = (task >> 2) & 31, grp = (task - 1024) >> 2;
    const int m0 = samp ? MP + 64 * grp : b * SEQ + 64 * j;
    LAS float* sq = stg; LAS float* sk = stg + 512; LAS float* sa = stg + 1024; LAS float* sv = stg + 1536; LAS float* sg = stg + 2560;
    float w2c[16];
#pragma unroll
    for (int r = 0; r < 16; ++r) w2c[r] = F.in[IN_GW2][(l * 16 + r) * 128 + h * 32 + d];
    const float gb = F.in[IN_GB][l * 128 + h * 32 + d];
    float S[32];
#pragma unroll
    for (int i = 0; i < 32; ++i) S[i] = 0.f;
    if (PASS2 && !samp && j > 0) {
        float W = 1.f;
        for (int i = j - 1; i >= 0; --i) {
            const int pt = (b << 7) | (i << 2) | h;
            const float pl = SUMP[pt * 32 + d];
            const float* ds = SUMS + (size_t)pt * 2048 + lane;
#pragma unroll
            for (int dd = 0; dd < 32; ++dd) S[dd] += __shfl(W, dd) * ds[dd * 64];
            W *= pl;
        }
    }
    float pa = 1.f;
    const float gn = PASS2 ? F.in[IN_BNG][l * 256 + h * 64 + lane] : 0.f;
    for (int tb = 0; tb < 64; tb += 16) {
        LDS_WAIT(); asm volatile("" ::: "memory");
#pragma unroll
        for (int r = 0; r < 8; ++r) {
            const int t = tt0 + 2 * r; const bf16* zr = Z + (size_t)(m0 + tb + t) * NZ;
            const float qv = bf1(zr[ZC_Q + h * 32 + d]) * 0.17677669529663687f, kv = bf1(zr[ZC_K + h * 32 + d]);
            const v4u lr0 = *(const v4u*)(zr + ZC_LR), lr1 = *(const v4u*)(zr + ZC_LR + 8);
            float pre = gb;
            pre += bflo(lr0.x) * w2c[0] + bfhi(lr0.x) * w2c[1] + bflo(lr0.y) * w2c[2] + bfhi(lr0.y) * w2c[3] + bflo(lr0.z) * w2c[4] + bfhi(lr0.z) * w2c[5] + bflo(lr0.w) * w2c[6] + bfhi(lr0.w) * w2c[7];
            pre += bflo(lr1.x) * w2c[8] + bfhi(lr1.x) * w2c[9] + bflo(lr1.y) * w2c[10] + bfhi(lr1.y) * w2c[11] + bflo(lr1.z) * w2c[12] + bfhi(lr1.z) * w2c[13] + bflo(lr1.w) * w2c[14] + bfhi(lr1.w) * w2c[15];
            const float av = __expf(log_sigmoid_(pre) * (1.f / 16.f));
            pa *= av;
            sq[t * 32 + d] = qv; sk[t * 32 + d] = kv; sa[t * 32 + d] = av;
        }
#pragma unroll
        for (int t = 0; t < 16; ++t) { const bf16* zr = Z + (size_t)(m0 + tb + t) * NZ; sv[t * 64 + lane] = bf1(zr[ZC_V + h * 64 + lane]); if (PASS2) sg[t * 64 + lane] = bf1(zr[ZC_G + h * 64 + lane]); }
        LDS_WAIT(); asm volatile("" ::: "memory");
#pragma unroll 2
        for (int t = 0; t < 16; ++t) {
            if (PASS2 && samp && (t & 7) == 0) {
                const int bs = grp * 8 + ((tb + t) >> 3);
                const float* s0 = F.in[IN_SGLA] + (((size_t)l * DB + bs) * 4 + h) * 2048 + lane;
#pragma unroll
                for (int dd = 0; dd < 32; ++dd) S[dd] = s0[dd * 64];
            }
            const float vt = sv[t * 64 + lane]; float o = 0.f;
#pragma unroll
            for (int d4 = 0; d4 < 8; ++d4) {
                const f32x4 a4 = *(const LAS f32x4*)(sa + t * 32 + 4 * d4), k4 = *(const LAS f32x4*)(sk + t * 32 + 4 * d4);
                f32x4 q4 = (f32x4){0.f, 0.f, 0.f, 0.f}; if (PASS2) q4 = *(const LAS f32x4*)(sq + t * 32 + 4 * d4);
#pragma unroll
                for (int e = 0; e < 4; ++e) { S[4 * d4 + e] = a4[e] * S[4 * d4 + e] + k4[e] * vt; o += q4[e] * S[4 * d4 + e]; }
            }
            if (PASS2) {
                const int m = m0 + tb + t;
                const float ms = wave_sum(o * o) * (1.f / 64.f);
                const float on = o * (1.f / sqrtf(ms + LN_EPS)) * gn * siluf_(sg[t * 64 + lane]);
                Y[(size_t)m * D + 256 + h * 64 + lane] = (bf16)f2bf(on);
                if (samp && (t & 7) == 7) {
                    const int bs = grp * 8 + ((tb + t) >> 3);
                    float* so = F.out + O_GS + (((size_t)l * DB + bs) * 4 + h) * 2048 + lane;
#pragma unroll
                    for (int dd = 0; dd < 32; ++dd) so[dd * 64] = S[dd];
                }
            }
        }
    }
    if (!PASS2) {
        float* ds = SUMS + (size_t)task * 2048 + lane;
#pragma unroll
        for (int dd = 0; dd < 32; ++dd) ds[dd * 64] = S[dd];
        const float pt = pa * __shfl_xor(pa, 32);
        if (lane < 32) SUMP[task * 32 + d] = pt;
    } else if (!samp && j == 31) {
        float* so = F.out + O_GP + (((size_t)l * NB + b) * 4 + h) * 2048 + lane;
#pragma unroll
        for (int dd = 0; dd < 32; ++dd) so[dd * 64] = S[dd];
    }
}

__device__ __forceinline__ void token_mix(Frame& F, int l, int m) {
    const bf16* Z = (const bf16*)(F.ws + WS_Z); bf16* Y = (bf16*)(F.ws + WS_Y); const float* VV = (const float*)(F.ws + WS_VV);
    const int lane = F.lane, ch = 4 * lane;
    const bool samp = m >= MP;
    const int bq = samp ? (m - MP) >> 3 : m >> 11, t = samp ? (m - MP) & 7 : m & 2047, L = samp ? DSEQ : SEQ;
    const bf16* zr = Z + (size_t)m * NZ;
    const f32x4 zero4 = (f32x4){0.f, 0.f, 0.f, 0.f};
    {
        const float* hist = F.in[IN_SCA] + ((size_t)l * DB + bq) * 2 * 256 + ch;
        const f32x4 ab = ld_bf4(zr + ZC_AB + ch);
        const f32x4 x2 = ld_bf4(zr + ZC_AC + ch) * ld_bf4(zr + ZC_AH + ch);
        f32x4 x1, x0;
        if (t >= 1) x1 = ld_bf4(zr - NZ + ZC_AC + ch) * ld_bf4(zr - NZ + ZC_AH + ch); else x1 = samp ? *(const f32x4*)(hist + 256) : zero4;
        if (t >= 2) x0 = ld_bf4(zr - 2 * NZ + ZC_AC + ch) * ld_bf4(zr - 2 * NZ + ZC_AH + ch); else x0 = samp ? *(const f32x4*)(hist + t * 256) : zero4;
        const float* w = F.in[IN_ACW] + l * 3 * 256 + ch;
        const f32x4 ya = ab * (*(const f32x4*)(w) * x0 + *(const f32x4*)(w + 256) * x1 + *(const f32x4*)(w + 512) * x2);
        st_bf4(Y + (size_t)m * D + ch, ya);
        if (t >= L - 2) { float* o = F.out + (samp ? O_CAS + (((size_t)l * DB + bq) * 2 + (t - (L - 2))) * 256 : O_CAP + (((size_t)l * NB + bq) * 2 + (t - (L - 2))) * 256) + ch; *(f32x4*)o = x2; }
    }
    {
        const float* hist = F.in[IN_SCC] + ((size_t)l * DB + bq) * 30 * 256 + ch;
        const float* w = F.in[IN_CCW] + l * 31 * 256 + ch;
        f32x4 acc = *(const f32x4*)(F.in[IN_CCB] + l * 256 + ch);
        f32x4 cur = zero4;
        for (int jj = 0; jj < 31; ++jj) {
            const int tt = t + jj - 30; f32x4 val;
            if (tt >= 0) { const bf16* zz = zr + (ptrdiff_t)(jj - 30) * NZ; const f32x4 ca = ld_bf4(zz + ZC_CA + ch), cg = ld_bf4(zz + ZC_CG + ch);
#pragma unroll
                for (int e = 0; e < 4; ++e) val[e] = ca[e] * sigmoidf_(cg[e]); }
            else val = samp ? *(const f32x4*)(hist + (tt + 30) * 256) : zero4;
            acc += *(const f32x4*)(w + jj * 256) * val;
            cur = val;
        }
        const float mean = wave_sum((acc[0] + acc[1]) + (acc[2] + acc[3])) * (1.f / 256.f);
        acc = acc - mean;
        const float var = wave_sum((acc[0] * acc[0] + acc[1] * acc[1]) + (acc[2] * acc[2] + acc[3] * acc[3])) * (1.f / 256.f);
        const float rstd = 1.f / sqrtf(var + LN_EPS);
        const f32x4 g = *(const f32x4*)(F.in[IN_CLG] + l * 256 + ch), bb = *(const f32x4*)(F.in[IN_CLB] + l * 256 + ch);
        f32x4 y = acc * rstd * g + bb;
#pragma unroll
        for (int e = 0; e < 4; ++e) y[e] = siluf_(y[e]);
        st_bf4(Y + (size_t)m * D + 512 + ch, y);
        if (!samp) { if (t >= L - 30) *(f32x4*)(F.out + O_CCP + (((size_t)l * NB + bq) * 30 + (t - (L - 30))) * 256 + ch) = cur; }
        else {
            float* o = F.out + O_CCS + ((size_t)l * DB + bq) * 30 * 256 + ch;
            *(f32x4*)(o + (22 + t) * 256) = cur;
#pragma unroll
            for (int k = 0; k < 3; ++k) { const int i = t + 8 * k; if (i < 22) *(f32x4*)(o + i * 256) = *(const f32x4*)(hist + (8 + i) * 256); }
        }
    }
    {
        f32x4 u = ld_bf4(zr + ZC_U + ch);
#pragma unroll
        for (int e = 0; e < 4; ++e) u[e] = gelu_tanh(u[e]);
        const int g = lane >> 4, tt = samp ? t : (t & 127);
        const float* wrow = F.in[IN_DWS] + (((size_t)l * 4 + g) * 128 + tt) * 128;
        const float bias = F.in[IN_DBS][(l * 4 + g) * 128 + tt];
        f32x4 f = (f32x4){bias, bias, bias, bias};
        const float* vrow = VV + (size_t)(m - tt) * 256 + ch;
        for (int s = 0; s <= tt; ++s) f += wrow[s] * *(const f32x4*)(vrow + (size_t)s * 256);
        st_bf4(Y + (size_t)m * D + 768 + ch, u * f);
    }
}

constexpr int PH_PER_LAYER = 8, N_PHASES = 1 + 2 * PH_PER_LAYER;
#define IN(k) (lo <= (k) && (k) < hi)
#define SEAM(k) do { if (IN(k) && IN((k) + 1)) xcd_barrier(bar); } while (0)
template <int L> __device__ __forceinline__ void layer_phases(Frame& F, const Args& args, const XcdBarrier& bar, const int lo, const int hi, const int gw, const int NGW) {
        constexpr int l = L; constexpr int p0 = 1 + L * PH_PER_LAYER;
        unsigned char* wl = args.ws + WS_W + (size_t)l * W_LAYER;
        bf16* XA = (bf16*)(args.ws + WS_XNA); bf16* XB = (bf16*)(args.ws + WS_XNB);
        float* yout = args.out + O_Y;
        if (IN(p0 + 0)) {
            pg8::Gemm g{XA, (const bf16*)(wl + W_IN_OFF), M, NZ, D}; pg8::StaticOrder S; S.init(M, NZ, F.G, (int)blockIdx.x);
            pg8::EpiBf16<0> E{(bf16*)(args.ws + WS_Z), NZ};
            pg8::gemm_phase<pg8::EpiBf16<0>, pg8::StaticOrder, true, true>(F.lds + RING_OFF, g, S, E);
            SEAM(p0 + 0);
        }
        if (IN(p0 + 1)) {
            for (int m = gw; m < M; m += NGW) vv_row(F, l, m);
            LAS float* stg = (LAS float*)(F.lds + RING_OFF + F.wave * 16384);
            for (int task = gw; task < 1024; task += NGW) gla_task<false>(F, l, task, stg);
            SEAM(p0 + 1);
        }
        if (IN(p0 + 2)) {
            LAS float* stg = (LAS float*)(F.lds + RING_OFF + F.wave * 16384);
            for (int task = gw; task < 1088; task += NGW) gla_task<true>(F, l, task, stg);
            for (int m = gw; m < M; m += NGW) token_mix(F, l, m);
            SEAM(p0 + 2);
        }
        if (IN(p0 + 3)) {
            pg8::Gemm g{(const bf16*)(args.ws + WS_Y), (const bf16*)(wl + W_OUT_OFF), M, D, D}; pg8::StaticOrder S; S.init(M, D, F.G, (int)blockIdx.x);
            pg8::EpiRes E{l == 0 ? args.in[IN_XP] : yout, l == 0 ? args.in[IN_XS] : yout + (size_t)MP * D, MP, yout, D, ALPHA};
            pg8::gemm_phase<pg8::EpiRes, pg8::StaticOrder, true, true>(F.lds + RING_OFF, g, S, E);
            SEAM(p0 + 3);
        }
        if (IN(p0 + 4)) { ln_phase<true>(F, yout, args.in[IN_L1G] + l * D, args.in[IN_L1B] + l * D, XB); SEAM(p0 + 4); }
        if (IN(p0 + 5)) {
            pg8::Gemm g{XB, (const bf16*)(wl + W_FF1_OFF), M, FF, D}; pg8::StaticOrder S; S.init(M, FF, F.G, (int)blockIdx.x);
            pg8::EpiBf16<2> E{(bf16*)(args.ws + WS_H), FF};
            pg8::gemm_phase<pg8::EpiBf16<2>, pg8::StaticOrder, true, true>(F.lds + RING_OFF, g, S, E);
            SEAM(p0 + 5);
        }
        if (IN(p0 + 6)) {
            pg8::Gemm g{(const bf16*)(args.ws + WS_H), (const bf16*)(wl + W_FF2_OFF), M, D, FF}; pg8::StaticOrder S; S.init(M, D, F.G, (int)blockIdx.x);
            pg8::EpiRes E{yout, yout + (size_t)MP * D, MP, yout, D, ALPHA};
            pg8::gemm_phase<pg8::EpiRes, pg8::StaticOrder, true, true>(F.lds + RING_OFF, g, S, E);
            SEAM(p0 + 6);
        }
        if (IN(p0 + 7)) { ln_phase<true>(F, yout, args.in[IN_L2G] + l * D, args.in[IN_L2B] + l * D, XA); SEAM(p0 + 7); }
}
__global__ void __launch_bounds__(NWAVES * 64, 2) mk_fwd(Args args) {
    extern __shared__ __attribute__((aligned(16))) unsigned char lds[];
    Frame F;
    F.lds = (LAS unsigned char*)lds;
    F.MISC = (volatile LAS unsigned*)(F.lds + MISC_OFF);
    F.tid = threadIdx.x; F.lane = F.tid & 63; F.wave = __builtin_amdgcn_readfirstlane(F.tid >> 6);
    F.G = gridDim.x; { const int bx = blockIdx.x; F.vcu = (F.G % 8 == 0) ? (bx % 8) * (F.G / 8) + bx / 8 : bx; }
    F.in = args.in; F.out = args.out; F.ws = args.ws;
    gu32* ctl = (gu32*)(args.ws + WS_CTL);
    for (int u = F.tid; u < (LDS_BYTES - LDSCTL_OFF) / 4; u += NWAVES * 64) ((LAS unsigned*)(F.lds + LDSCTL_OFF))[u] = 0u;
    __syncthreads();
    XcdBarrier bar; bar.bar = (unsigned*)(ctl + CW_BAR); bar.x = 0; bar.st = nullptr;
    const int lo = args.ph_lo, hi = args.ph_hi;
    const bool one_launch = (hi - lo) > 1;
    if (one_launch) bar = xcd_barrier_post((unsigned*)(ctl + CW_BAR), F.MISC + 8);
    const int gw = F.vcu * NWAVES + F.wave, NGW = F.G * NWAVES;

    if (IN(0)) { p0_prologue(F); SEAM(0); }

    layer_phases<0>(F, args, bar, lo, hi, gw, NGW);
    layer_phases<1>(F, args, bar, lo, hi, gw, NGW);
#undef IN
#undef SEAM
}

extern "C" void kernel_launch(void* const* d_in, const int* in_sizes, int n_in, void* d_out, int out_size, void* d_ws, size_t ws_size, hipStream_t stream) {
    static int grid = 0;
    if (grid == 0) {
        if (n_in != 25 || (size_t)out_size != O_END || ws_size < WS_END) { fprintf(stderr, "kernel_launch: unexpected sizes n_in %d out %d ws %zu\n", n_in, out_size, ws_size); grid = -1; return; }
        int dev = 0, cus = 0;
        if (hipGetDevice(&dev) != hipSuccess || hipDeviceGetAttribute(&cus, hipDeviceAttributeMultiprocessorCount, dev) != hipSuccess) { grid = -1; return; }
        if (hipFuncSetAttribute((const void*)mk_fwd, hipFuncAttributeMaxDynamicSharedMemorySize, LDS_BYTES) != hipSuccess) { fprintf(stderr, "kernel_launch: hipFuncSetAttribute failed\n"); grid = -1; return; }
        (void)hipGetLastError();
        grid = cus;
    }
    if (grid < 0) return;
    (void)hipMemsetAsync((char*)d_ws + WS_CTL, 0, CTL_ZERO_BYTES, stream);
    Args a{};
    for (int i = 0; i < 25; ++i) a.in[i] = (const float*)d_in[i];
    a.out = (float*)d_out; a.ws = (unsigned char*)d_ws;
#if MK_N_LAUNCHES == 1
    a.ph_lo = 0; a.ph_hi = N_PHASES;
    hipLaunchKernelGGL(mk_fwd, dim3(grid), dim3(NWAVES * 64), LDS_BYTES, stream, a);
#else
    for (int p = 0; p < N_PHASES; ++p) { a.ph_lo = p; a.ph_hi = p + 1; hipLaunchKernelGGL(mk_fwd, dim3(grid), dim3(NWAVES * 64), LDS_BYTES, stream, a); }
#endif
}
```

```cpp
#include <hip/hip_runtime.h>
#include <cstdio>
#include <cstdint>
namespace pg8 {
#define PG8_LAS __attribute__((address_space(3)))
typedef unsigned short bf16_t;
typedef short bf16x8 __attribute__((ext_vector_type(8)));
typedef float f32x4 __attribute__((ext_vector_type(4)));
typedef unsigned u32x4 __attribute__((ext_vector_type(4)));
constexpr int BM = 256, BK = 64, HALF = 128, HTB = HALF * BK * 2  , STAGE_BYTES = 8 * HTB, NXCD = 8, WGM = 8;

__host__ __device__ __forceinline__ int lds_byte(int r, int c) { const int st = (r >> 4) * 2 + (c >> 5), rr = r & 15, cc = c & 31, ob = rr * 64 + cc * 2; return st * 1024 + (ob ^ (((ob >> 9) & 1) << 5)); }
__host__ __device__ __forceinline__ void stage_rc(int b, int& R, int& C) { const int st = b / 1024, sb = b % 1024, swz = sb ^ (((sb >> 9) & 1) << 5); R = (st >> 1) * 16 + swz / 64; C = (st & 1) * 32 + (swz % 64) / 2; }
__host__ __device__ __forceinline__ int perm32(int rho) { const int n = rho >> 4, i = rho & 15; return 8 * (i >> 2) + 4 * n + (i & 3); }

struct Unit { int pm, pn, kz; };
struct Gemm { const bf16_t* A; const bf16_t* Bt; int M, N, K, ld, kslice; };

struct StaticOrder {
    int nM, nN, nwg, G, c;
    __host__ __device__ void init(int M, int N, int G_, int c_) { nM = M / BM; nN = N / BM; nwg = nM * nN; G = G_; c = c_; }
    __host__ __device__ bool next(int i, Unit& u) const {
        const long L = (long)i * G + c; if (L >= nwg) return false;
        int wgid = (int)L; { const int q = nwg / NXCD, r = nwg % NXCD, xcd = wgid % NXCD, off = wgid / NXCD; wgid = (xcd < r ? xcd * (q + 1) : r * (q + 1) + (xcd - r) * q) + off; }
        const int nig = WGM * nN, gid = wgid / nig, fm = gid * WGM, gsz = (nM - fm) < WGM ? (nM - fm) : WGM;
        u.pm = fm + ((wgid % nig) % gsz); u.pn = (wgid % nig) / gsz; u.kz = 0; return true;
    }
    __device__ __forceinline__ void a_ready(const Unit&) const {}
    __device__ __forceinline__ void done(const Unit&) const {}
};


__device__ __forceinline__ unsigned cvt_pk_bf16(float lo, float hi) { unsigned r; asm volatile("v_cvt_pk_bf16_f32 %0, %1, %2" : "=v"(r) : "v"(lo), "v"(hi)); return r; }

template <int ACT> struct EpiBf16 {
    static constexpr bool PERM = true, AFTER_DRAIN = false;
    bf16_t* O; int ldc;
    __device__ __forceinline__ void operator()(const f32x4 (&acc)[2][2][4][2], const Unit& u, int wr, int wc, int fr, int fq) const {
        const int row0 = u.pm * BM + wr * 64 + fr; const int col0 = u.pn * BM + wc * 32 + 8 * fq;
#pragma unroll
        for (int ai = 0; ai < 2; ++ai)
#pragma unroll
            for (int m = 0; m < 4; ++m) { bf16_t* rowp = O + (size_t)(row0 + ai * HALF + m * 16) * ldc + col0;
#pragma unroll
                for (int bj = 0; bj < 2; ++bj) { f32x4 v0 = acc[ai][bj][m][0], v1 = acc[ai][bj][m][1];
                    if (ACT == 2) {
#pragma unroll
                        for (int e = 0; e < 4; ++e) { const float a = fmaxf(v0[e], 0.f), b = fmaxf(v1[e], 0.f); v0[e] = a * a; v1[e] = b * b; } }
                    u32x4 w; w.x = cvt_pk_bf16(v0[0], v0[1]); w.y = cvt_pk_bf16(v0[2], v0[3]); w.z = cvt_pk_bf16(v1[0], v1[1]); w.w = cvt_pk_bf16(v1[2], v1[3]);
                    *(u32x4*)(rowp + bj * HALF) = w; } }
    }
};

struct EpiRes {
    static constexpr bool PERM = false, AFTER_DRAIN = false;
    const float* resA; const float* resB; int split; float* out; int ldc; float alpha;
    __device__ __forceinline__ void operator()(const f32x4 (&acc)[2][2][4][2], const Unit& u, int wr, int wc, int fr, int fq) const {
        const int row0 = u.pm * BM + wr * 64 + fr, col0 = u.pn * BM + wc * 32 + 4 * fq;
        const float* rb = (u.pm * BM < split) ? resA : (resB - (size_t)split * ldc);
#pragma unroll
        for (int ai = 0; ai < 2; ++ai)
#pragma unroll
            for (int m = 0; m < 4; ++m) { const size_t off = (size_t)(row0 + ai * HALF + m * 16) * ldc + col0;
#pragma unroll
                for (int bj = 0; bj < 2; ++bj)
#pragma unroll
                    for (int n = 0; n < 2; ++n) { const f32x4 r = *(const f32x4*)(rb + off + bj * HALF + n * 16); *(f32x4*)(out + off + bj * HALF + n * 16) = r * alpha + acc[ai][bj][m][n]; } }
    }
};

struct EpiPart {
    static constexpr bool PERM = false, AFTER_DRAIN = false;
    float* P;
    __device__ __forceinline__ void operator()(const f32x4 (&acc)[2][2][4][2], const Unit& u, int wr, int wc, int fr, int fq) const {
        const int row0 = (u.pm - 64) * BM + wr * 64 + fr, col0 = u.pn * BM + wc * 32 + 4 * fq;
        float* base = P + (size_t)u.kz * 1024 * 1024;
#pragma unroll
        for (int ai = 0; ai < 2; ++ai)
#pragma unroll
            for (int m = 0; m < 4; ++m) { const size_t off = (size_t)(row0 + ai * HALF + m * 16) * 1024 + col0;
#pragma unroll
                for (int bj = 0; bj < 2; ++bj)
#pragma unroll
                    for (int n = 0; n < 2; ++n) *(f32x4*)(base + off + bj * HALF + n * 16) = acc[ai][bj][m][n]; }
    }
};
struct SplitOrder {
    int nsub, G, c;
    __host__ __device__ void init(int SK, int G_, int c_) { nsub = 16 * SK; G = G_; c = c_; }
    __host__ __device__ bool next(int i, Unit& u) const { const int L = i * G + c; if (L >= nsub) return false; u.pn = L & 3; u.pm = 64 + ((L >> 2) & 3); u.kz = L >> 4; return true; }
    __device__ __forceinline__ void a_ready(const Unit&) const {}
    __device__ __forceinline__ void done(const Unit&) const {}
};

template <class Epi, class Sched, bool ALIGN_EPI = false, bool SP2 = false>
__device__ __forceinline__ void gemm_phase(PG8_LAS unsigned char* lds, const Gemm g, const Sched& S, const Epi& E) {
    const int tid = threadIdx.x, wid = __builtin_amdgcn_readfirstlane(tid >> 6), lane = tid & 63, wr = wid >> 2, wc = wid & 3, fr = lane & 15, fq = lane >> 4;
    const int K = g.K, nt = K / BK;
    unsigned voffA[2], voffB[2];
#pragma unroll
    for (int i = 0; i < 2; ++i) { int R, C; stage_rc(tid * 16 + i * 8192, R, C); const int Rb = Epi::PERM ? ((R & ~31) + perm32(R & 31)) : R;
        voffA[i] = (unsigned)(R * g.ld + C) * 2u; voffB[i] = (unsigned)(Rb * g.ld + C) * 2u; }
    const size_t kstep = (size_t)(BK * 2);
    const size_t hstep = (size_t)HALF * g.ld * 2;
    const size_t tstep = 2 * hstep;
    const unsigned ldsw = (unsigned)wid * 1024u;
    const int aoff = lds_byte(wr * 64 + fr, fq * 8), boff = lds_byte(wc * 32 + fr, fq * 8);
#define PG8_SA(b, h) (((b) * 2 + (h)) * HTB)
#define PG8_SB(b, h) ((4 + (b) * 2 + (h)) * HTB)
#define PG8_STAGE(bufoff, gbase, voff) do { _Pragma("unroll") for (int _i = 0; _i < 2; ++_i) \
        __builtin_amdgcn_global_load_lds((const unsigned*)((const char*)(gbase) + (voff)[_i]), (PG8_LAS unsigned*)(lds + (bufoff) + ldsw + _i * 8192), 16, 0, 0); } while (0)
#define PG8_LDA(dst, b, h) do { _Pragma("unroll") for (int m = 0; m < 4; ++m) _Pragma("unroll") for (int k = 0; k < 2; ++k) dst[m][k] = *(const PG8_LAS bf16x8*)(lds + PG8_SA(b, h) + aoff + m * 2048 + k * 1024); } while (0)
#define PG8_LDB(dst, b, h) do { _Pragma("unroll") for (int n = 0; n < 2; ++n) _Pragma("unroll") for (int k = 0; k < 2; ++k) dst[n][k] = *(const PG8_LAS bf16x8*)(lds + PG8_SB(b, h) + boff + n * 2048 + k * 1024); } while (0)
#define PG8_MMA(ai, bj, At, Bt) do { __builtin_amdgcn_s_setprio(1); _Pragma("unroll") for (int m = 0; m < 4; ++m) _Pragma("unroll") for (int n = 0; n < 2; ++n) _Pragma("unroll") for (int k = 0; k < 2; ++k) \
        acc[ai][bj][m][n] = __builtin_amdgcn_mfma_f32_16x16x32_bf16(Bt[n][k], At[m][k], acc[ai][bj][m][n], 0, 0, 0); __builtin_amdgcn_s_setprio(0); } while (0)
#define PG8_WAIT_V(n) asm volatile("s_waitcnt vmcnt(" #n ")" ::: "memory")
#define PG8_WAIT_L(n) asm volatile("s_waitcnt lgkmcnt(" #n ")" ::: "memory")
#define PG8_BAR __builtin_amdgcn_s_barrier()
#define PG8_SCHED __builtin_amdgcn_sched_barrier(0)
    Unit cur, nxt; int ui = 0;
    if (!S.next(0, cur)) return;
    f32x4 acc[2][2][4][2];
#pragma unroll
    for (int a = 0; a < 2; ++a)
#pragma unroll
        for (int b = 0; b < 2; ++b)
#pragma unroll
            for (int m = 0; m < 4; ++m)
#pragma unroll
                for (int n = 0; n < 2; ++n) acc[a][b][m][n] = (f32x4){0.f, 0.f, 0.f, 0.f};
    bf16x8 At[4][2], B0[2][2], B1[2][2];
    const char* cA = (const char*)g.A + (size_t)cur.pm * tstep + (size_t)cur.kz * g.kslice * 2; const char* cB = (const char*)g.Bt + (size_t)cur.pn * tstep + (size_t)cur.kz * g.kslice * 2;
    S.a_ready(cur);
    if constexpr (SP2) {
        PG8_STAGE(PG8_SB(0, 0), cB, voffB); PG8_STAGE(PG8_SB(0, 1), cB + hstep, voffB); PG8_STAGE(PG8_SA(0, 0), cA, voffA); PG8_STAGE(PG8_SA(0, 1), cA + hstep, voffA);
        if (wr == 1) PG8_BAR;
        PG8_WAIT_V(2); PG8_BAR;
        PG8_STAGE(PG8_SB(1, 0), cB + kstep, voffB); PG8_STAGE(PG8_SA(1, 0), cA + kstep, voffA); PG8_STAGE(PG8_SB(1, 1), cB + hstep + kstep, voffB);
        PG8_WAIT_V(6); PG8_BAR;
    } else {
        PG8_STAGE(PG8_SB(0, 0), cB, voffB); PG8_STAGE(PG8_SA(0, 0), cA, voffA); PG8_STAGE(PG8_SB(0, 1), cB + hstep, voffB); PG8_STAGE(PG8_SA(0, 1), cA + hstep, voffA);
        if (wr == 1) PG8_BAR;
        PG8_WAIT_V(4); PG8_BAR;
        PG8_STAGE(PG8_SB(1, 0), cB + kstep, voffB); PG8_STAGE(PG8_SA(1, 0), cA + kstep, voffA); PG8_STAGE(PG8_SB(1, 1), cB + hstep + kstep, voffB);
        PG8_WAIT_V(6); PG8_BAR;
    }
    for (;;) {
        const bool has_next = S.next(ui + 1, nxt);
        const char* nA = has_next ? (const char*)g.A + (size_t)nxt.pm * tstep + (size_t)nxt.kz * g.kslice * 2 : cA; const char* nB = has_next ? (const char*)g.Bt + (size_t)nxt.pn * tstep + (size_t)nxt.kz * g.kslice * 2 : cB;
        for (int t = 0; t < nt; t += 2) {
            const bool last = (t == nt - 2);
            const char* a1 = cA + (size_t)(t + 1) * kstep;
            const char* a2 = last ? nA : cA + (size_t)(t + 2) * kstep; const char* b2 = last ? nB : cB + (size_t)(t + 2) * kstep;
            const char* a3 = a2 + kstep; const char* b3 = b2 + kstep;
            if (last && has_next) S.a_ready(nxt);
            if constexpr (SP2) {
            PG8_LDB(B0, 0, 0); PG8_LDB(B1, 0, 1); PG8_SCHED; PG8_LDA(At, 0, 0); PG8_STAGE(PG8_SA(1, 1), a1 + hstep, voffA);
            PG8_WAIT_V(8); PG8_WAIT_L(0); PG8_BAR; PG8_MMA(0, 0, At, B0); PG8_MMA(0, 1, At, B1); PG8_BAR; PG8_SCHED;
            PG8_LDA(At, 0, 1); PG8_STAGE(PG8_SB(0, 0), b2, voffB); PG8_STAGE(PG8_SB(0, 1), b2 + hstep, voffB); PG8_STAGE(PG8_SA(0, 0), a2, voffA);
            PG8_WAIT_V(8); PG8_WAIT_L(0); PG8_BAR; PG8_MMA(1, 0, At, B0); PG8_MMA(1, 1, At, B1); PG8_BAR; PG8_SCHED;
            PG8_LDB(B0, 1, 0); PG8_LDB(B1, 1, 1); PG8_SCHED; PG8_LDA(At, 1, 0); PG8_STAGE(PG8_SA(0, 1), a2 + hstep, voffA);
            PG8_WAIT_V(8); PG8_WAIT_L(0); PG8_BAR; PG8_MMA(0, 0, At, B0); PG8_MMA(0, 1, At, B1); PG8_BAR; PG8_SCHED;
            PG8_LDA(At, 1, 1); PG8_STAGE(PG8_SB(1, 0), b3, voffB); PG8_STAGE(PG8_SB(1, 1), b3 + hstep, voffB); PG8_STAGE(PG8_SA(1, 0), a3, voffA);
            PG8_WAIT_V(8); PG8_WAIT_L(0); PG8_BAR; PG8_MMA(1, 0, At, B0); PG8_MMA(1, 1, At, B1); PG8_BAR; PG8_SCHED;
            } else {
            PG8_LDB(B0, 0, 0); PG8_SCHED; PG8_LDA(At, 0, 0); PG8_STAGE(PG8_SA(1, 1), a1 + hstep, voffA);
            PG8_WAIT_L(8); PG8_BAR; PG8_WAIT_L(0); PG8_MMA(0, 0, At, B0); PG8_BAR; PG8_SCHED;
            PG8_LDB(B1, 0, 1); PG8_STAGE(PG8_SB(0, 0), b2, voffB);
            PG8_BAR; PG8_WAIT_L(0); PG8_MMA(0, 1, At, B1); PG8_BAR;
            PG8_LDA(At, 0, 1); PG8_STAGE(PG8_SA(0, 0), a2, voffA);
            PG8_BAR; PG8_WAIT_L(0); PG8_MMA(1, 0, At, B0); PG8_BAR; PG8_SCHED;
            PG8_STAGE(PG8_SB(0, 1), b2 + hstep, voffB);
            PG8_WAIT_V(6); PG8_BAR; PG8_MMA(1, 1, At, B1); PG8_BAR;
            PG8_LDB(B0, 1, 0); PG8_SCHED; PG8_LDA(At, 1, 0); PG8_STAGE(PG8_SA(0, 1), a2 + hstep, voffA);
            PG8_WAIT_L(8); PG8_BAR; PG8_WAIT_L(0); PG8_MMA(0, 0, At, B0); PG8_BAR; PG8_SCHED;
            PG8_LDB(B1, 1, 1); PG8_STAGE(PG8_SB(1, 0), b3, voffB);
            PG8_BAR; PG8_WAIT_L(0); PG8_MMA(0, 1, At, B1); PG8_BAR;
            PG8_LDA(At, 1, 1); PG8_STAGE(PG8_SA(1, 0), a3, voffA);
            PG8_BAR; PG8_WAIT_L(0); PG8_MMA(1, 0, At, B0); PG8_BAR; PG8_SCHED;
            PG8_STAGE(PG8_SB(1, 1), b3 + hstep, voffB);
            PG8_WAIT_V(6); PG8_BAR; PG8_MMA(1, 1, At, B1); PG8_BAR;
            }
        }
        if constexpr (ALIGN_EPI) { if (wr == 0) PG8_BAR; }
        if constexpr (!Epi::AFTER_DRAIN) { E(acc, cur, wr, wc, fr, fq); S.done(cur); }
        if (!has_next) break;
#pragma unroll
        for (int a = 0; a < 2; ++a)
#pragma unroll
            for (int b = 0; b < 2; ++b)
#pragma unroll
                for (int m = 0; m < 4; ++m)
#pragma unroll
                    for (int n = 0; n < 2; ++n) acc[a][b][m][n] = (f32x4){0.f, 0.f, 0.f, 0.f};
        cur = nxt; cA = nA; cB = nB; ++ui;
        if constexpr (ALIGN_EPI) { if (wr == 1) PG8_BAR; }
    }
    PG8_WAIT_V(0);
    if constexpr (!ALIGN_EPI) { if (wr == 0) PG8_BAR; }
    PG8_BAR;
    if constexpr (Epi::AFTER_DRAIN) { E.fused(acc, cur, wr, wc, fr, fq, lds, wid, lane); S.done(cur); }
#undef PG8_SA
#undef PG8_SB
#undef PG8_STAGE
#undef PG8_LDA
#undef PG8_LDB
#undef PG8_MMA
#undef PG8_WAIT_V
#undef PG8_WAIT_L
#undef PG8_BAR
#undef PG8_SCHED
}
}

constexpr int NWAVES = 8;
#ifndef MK_N_LAUNCHES
#define MK_N_LAUNCHES 1
#endif

constexpr int D = 1024, NB = 8, SEQ = 2048, DEPTH = 2, DB = 128, DSEQ = 8, FF = 4096;
constexpr int MP = NB * SEQ, MS = DB * DSEQ, M = MP + MS;
constexpr int INC = 2576, NZ = 2816;
constexpr int ZC_AB = 0, ZC_AC = 256, ZC_AH = 512, ZC_Q = 768, ZC_K = 896, ZC_V = 1024, ZC_G = 1280, ZC_CA = 1536, ZC_CG = 1792, ZC_U = 2048, ZC_VV = 2304, ZC_LR = 2560;
constexpr float LN_EPS = 1e-5f;
constexpr float ALPHA = 1.41421356237309515f;
constexpr size_t O_Y = 0, O_CAP = (size_t)M * D, O_CAS = O_CAP + 2 * 8 * 2 * 256, O_GP = O_CAS + 2 * 128 * 2 * 256, O_GS = O_GP + 2 * 8 * 4 * 32 * 64,
                 O_CCP = O_GS + (size_t)2 * 128 * 4 * 32 * 64, O_CCS = O_CCP + 2 * 8 * 30 * 256, O_CV = O_CCS + (size_t)2 * 128 * 30 * 256, O_END = O_CV + (size_t)2 * 128 * 8 * 256;

constexpr size_t MiB = 1u << 20;
constexpr size_t WS_CTL = 0, CTL_ZERO_BYTES = 1 * MiB;
constexpr size_t WS_W = 1 * MiB;
constexpr size_t W_IN_OFF = 0, W_OUT_OFF = (size_t)NZ * D * 2, W_FF1_OFF = W_OUT_OFF + (size_t)D * D * 2, W_FF2_OFF = W_FF1_OFF + (size_t)FF * D * 2, W_LAYER = W_FF2_OFF + (size_t)D * FF * 2;
static_assert(W_LAYER == 24641536, "23.5 MiB per layer");
constexpr size_t WS_XNA = 48 * MiB, WS_XNB = 82 * MiB;
constexpr size_t WS_R = 116 * MiB;
constexpr size_t WS_Z = WS_R, WS_Y = WS_R + (size_t)M * NZ * 2, WS_H = WS_R;
constexpr size_t WS_END = 256 * MiB;
static_assert(WS_W + 2 * W_LAYER <= WS_XNA && WS_Y + (size_t)M * D * 2 <= 252 * MiB && WS_H + (size_t)M * FF * 2 == 252 * MiB, "d_ws map");
constexpr size_t WS_VV = WS_XNB, WS_SUMS = WS_VV + (size_t)M * 256 * 4, WS_SUMP = WS_SUMS + (size_t)1024 * 2048 * 4;
static_assert(WS_SUMP + 1024 * 32 * 4 <= WS_R, "mixer scratch inside XNB");
constexpr int CW_TMO = 0, CW_BAR = 4096;

constexpr int RING_OFF = 0, RING_BYTES = 131072;
constexpr int LDSCTL_OFF = RING_BYTES, MISC_OFF = LDSCTL_OFF + 320;
constexpr int LDS_BYTES = 147456;

#define GAS __attribute__((address_space(1)))
#define LAS __attribute__((address_space(3)))
typedef unsigned short bf16;
typedef unsigned v4u __attribute__((ext_vector_type(4)));
typedef unsigned v2u __attribute__((ext_vector_type(2)));
typedef float f32x4 __attribute__((ext_vector_type(4)));
typedef GAS unsigned gu32;
#define RLX_AGENT __ATOMIC_RELAXED, __HIP_MEMORY_SCOPE_AGENT
#define LDS_WAIT() asm volatile("s_waitcnt lgkmcnt(0)" ::: "memory")
#define VM_WAIT() asm volatile("s_waitcnt vmcnt(0)" ::: "memory")
__device__ __forceinline__ unsigned f2bf(float f) { unsigned u = __builtin_bit_cast(unsigned, f); return (u + 0x7fffu + ((u >> 16) & 1u)) >> 16; }
__device__ __forceinline__ unsigned pk2(float lo, float hi) { return f2bf(lo) | (f2bf(hi) << 16); }
__device__ __forceinline__ float bflo(unsigned w) { return __uint_as_float(w << 16); }
__device__ __forceinline__ float bfhi(unsigned w) { return __uint_as_float(w & 0xffff0000u); }
__device__ __forceinline__ float bf1(bf16 h) { return __uint_as_float((unsigned)h << 16); }
__device__ __forceinline__ f32x4 ld_bf4(const bf16* p) { const v2u w = *(const v2u*)p; return (f32x4){bflo(w.x), bfhi(w.x), bflo(w.y), bfhi(w.y)}; }
__device__ __forceinline__ void st_bf4(bf16* p, f32x4 v) { v2u w; w.x = pk2(v[0], v[1]); w.y = pk2(v[2], v[3]); *(v2u*)p = w; }
__device__ __forceinline__ float sigmoidf_(float x) { return 1.f / (1.f + __expf(-x)); }
__device__ __forceinline__ float siluf_(float x) { return x * sigmoidf_(x); }
__device__ __forceinline__ float gelu_tanh(float x) { const float u = 0.7978845608028654f * (x + 0.044715f * x * x * x); const float t = 1.f - 2.f / (1.f + __expf(2.f * u)); return 0.5f * x * (1.f + t); }
__device__ __forceinline__ float wave_sum(float v) {
#pragma unroll
    for (int o = 1; o < 64; o <<= 1) v += __shfl_xor(v, o);
    return v;
}

#define XB_TMO      128
#define XB_XCNT(j)  (256  + 64 * (j))
#define XB_XSUB(j)  (1280 + 64 * (j))
#define XB_XGEN(j)  (2304 + 64 * (j))
#define XB_TOP      3328
#define XB_TOPGEN   3392
#define XCD_BAR_WORDS 3456
#define XB_SPIN_CAP (1u << 18)
__device__ __forceinline__ unsigned xb_ld(unsigned* p)              { return __hip_atomic_load(p, __ATOMIC_RELAXED, __HIP_MEMORY_SCOPE_AGENT); }
__device__ __forceinline__ unsigned xb_add(unsigned* p, unsigned v) { return __hip_atomic_fetch_add(p, v, __ATOMIC_RELAXED, __HIP_MEMORY_SCOPE_AGENT); }
__device__ __forceinline__ unsigned xb_xcc_id() { return (unsigned)__builtin_amdgcn_s_getreg((3 << 11) | 20) & 0xFu; }
#define XB_SPIN(cond, bar) do { unsigned _sp = 0; while (cond) { __builtin_amdgcn_s_sleep(1); \
    if ((++_sp & 255u) == 0u) { if (xb_ld(&(bar)[XB_TMO])) break; if (_sp > XB_SPIN_CAP) { atomicAdd(&(bar)[XB_TMO], 1u); break; } } } } while (0)
struct XcdBarrier { unsigned* bar; unsigned x; volatile LAS unsigned* st; };
__device__ __forceinline__ XcdBarrier xcd_barrier_post(unsigned* bar, volatile LAS unsigned* st) {
    XcdBarrier b; b.bar = bar; b.x = xb_xcc_id(); b.st = st;
    if (threadIdx.x == 0) (void)xb_add(&bar[XB_XCNT(b.x)], 1u);
    return b;
}
__device__ __forceinline__ void xcd_barrier_complete(unsigned* bar, unsigned x, unsigned& nloc, unsigned& nx) {
    const unsigned G = gridDim.x * gridDim.y * gridDim.z;
    unsigned sum, cnt, mine, sp = 0u;
    for (;;) {
        sum = 0u; cnt = 0u; mine = 0u;
#pragma unroll
        for (unsigned j = 0; j < 16; ++j) { const unsigned c = xb_ld(&bar[XB_XCNT(j)]); sum += c; cnt += (c > 0u) ? 1u : 0u; mine = (j == x) ? c : mine; }
        if (sum == G) break;
        __builtin_amdgcn_s_sleep(1);
        if ((++sp & 255u) == 0u) { if (xb_ld(&bar[XB_TMO])) break; if (sp > XB_SPIN_CAP) { atomicAdd(&bar[XB_TMO], 1u); break; } }
    }
    nloc = mine > 0u ? mine : 1u; nx = cnt > 0u ? cnt : 1u;
}
__device__ __forceinline__ void xcd_barrier(const XcdBarrier& b) {
    asm volatile("s_waitcnt vmcnt(0)" ::: "memory");
    __syncthreads();
    if (threadIdx.x == 0) {
        unsigned* bar = b.bar;
        __builtin_amdgcn_s_waitcnt(0);
        unsigned nloc = b.st[0], nx = b.st[1];
        if (nloc == 0u) { xcd_barrier_complete(bar, b.x, nloc, nx); b.st[0] = nloc; b.st[1] = nx; }
        const unsigned old = xb_add(&bar[XB_XSUB(b.x)], 1u);
        const unsigned gen = old / nloc;
        if (old + 1u == (gen + 1u) * nloc) {
            __builtin_amdgcn_fence(__ATOMIC_RELEASE, "agent");
            asm volatile("s_waitcnt vmcnt(0)" ::: "memory");
            const unsigned og = xb_add(&bar[XB_TOP], 1u);
            const unsigned tg = og / nx;
            if (og + 1u == (tg + 1u) * nx) xb_add(&bar[XB_TOPGEN], 1u);
            else XB_SPIN(xb_ld(&bar[XB_TOPGEN]) == tg, bar);
            __builtin_amdgcn_fence(__ATOMIC_ACQUIRE, "agent");
            xb_add(&bar[XB_XGEN(b.x)], 1u);
            asm volatile("s_waitcnt vmcnt(0)" ::: "memory");
        } else {
            XB_SPIN(xb_ld(&bar[XB_XGEN(b.x)]) == gen, bar);
            __builtin_amdgcn_fence(__ATOMIC_ACQUIRE, "agent");
            asm volatile("s_waitcnt vmcnt(0)" ::: "memory");
        }
    }
    __syncthreads();
}

struct Args { const float* in[25]; float* out; unsigned char* ws; int ph_lo, ph_hi; };
struct Frame {
    LAS unsigned char* lds;
    volatile LAS unsigned* MISC;
    int tid, lane, wave, vcu, G;
    const float* const* in;
    float* out; unsigned char* ws;
};
#define IN_XP 0
#define IN_XS 1
#define IN_SCA 2
#define IN_SGLA 3
#define IN_SCC 4
#define IN_WIN 5
#define IN_ACW 6
#define IN_GW2 7
#define IN_GB 8
#define IN_BNG 9
#define IN_CCW 10
#define IN_CCB 11
#define IN_CLG 12
#define IN_CLB 13
#define IN_DLG 14
#define IN_DLB 15
#define IN_DWS 16
#define IN_DBS 17
#define IN_WOUT 18
#define IN_L1G 19
#define IN_L1B 20
#define IN_FF1 21
#define IN_FF2 22
#define IN_L2G 23
#define IN_L2B 24

__device__ __forceinline__ int zmap(int c) { return c < 1536 ? c : (c < 2560 ? c + 16 : (c < 2576 ? c - 1024 : -1)); }
template <bool MAPIN>
__device__ __forceinline__ void p0_transpose_item(const float* W, int K, int Nsrc, int Ndst, bf16* WT, LAS float* scr, int item, int lane) {
    const int nblk = Ndst / 32, kb = item / nblk, nb = item % nblk, k0 = 64 * kb, n0 = 32 * nb;
    int sc = n0 + (lane & 31); if (MAPIN) sc = zmap(sc);
#pragma unroll 8
    for (int i = 0; i < 32; ++i) { const int kk = 2 * i + (lane >> 5); scr[kk * 33 + (lane & 31)] = (sc >= 0) ? W[(size_t)(k0 + kk) * Nsrc + sc] : 0.f; }
    LDS_WAIT(); asm volatile("" ::: "memory");
    const int c = lane & 7;
#pragma unroll
    for (int j = 0; j < 4; ++j) { const int n = (lane >> 3) + 8 * j; const LAS float* s = scr + (8 * c) * 33 + n;
        v4u o; o.x = pk2(s[0 * 33], s[1 * 33]); o.y = pk2(s[2 * 33], s[3 * 33]); o.z = pk2(s[4 * 33], s[5 * 33]); o.w = pk2(s[6 * 33], s[7 * 33]);
        *(GAS v4u*)(WT + (size_t)(n0 + n) * K + k0 + 8 * c) = o; }
    LDS_WAIT(); asm volatile("" ::: "memory");
}
__device__ __forceinline__ void p0_prologue(Frame& F) {
    LAS float* scr = (LAS float*)(F.lds + RING_OFF + F.wave * 16384);
    const int gw = F.vcu * NWAVES + F.wave, NGW = F.G * NWAVES;
    constexpr int I_IN = (D / 64) * (NZ / 32), I_O = (D / 64) * (D / 32), I_1 = (D / 64) * (FF / 32), I_2 = (FF / 64) * (D / 32), I_L = I_IN + I_O + I_1 + I_2;
    for (int it = gw; it < 2 * I_L; it += NGW) {
        const int l = it / I_L; int r = it % I_L;
        unsigned char* wl = F.ws + WS_W + (size_t)l * W_LAYER;
        if (r < I_IN) { p0_transpose_item<true>(F.in[IN_WIN] + (size_t)l * D * INC, D, INC, NZ, (bf16*)(wl + W_IN_OFF), scr, r, F.lane); continue; } r -= I_IN;
        if (r < I_O) { p0_transpose_item<false>(F.in[IN_WOUT] + (size_t)l * D * D, D, D, D, (bf16*)(wl + W_OUT_OFF), scr, r, F.lane); continue; } r -= I_O;
        if (r < I_1) { p0_transpose_item<false>(F.in[IN_FF1] + (size_t)l * D * FF, D, FF, FF, (bf16*)(wl + W_FF1_OFF), scr, r, F.lane); continue; } r -= I_1;
        p0_transpose_item<false>(F.in[IN_FF2] + (size_t)l * FF * D, FF, D, D, (bf16*)(wl + W_FF2_OFF), scr, r, F.lane);
    }
    bf16* XA = (bf16*)(F.ws + WS_XNA);
    for (int m = gw; m < M; m += NGW) {
        const float* xr = (m < MP) ? F.in[IN_XP] + (size_t)m * D : F.in[IN_XS] + (size_t)(m - MP) * D;
#pragma unroll
        for (int j = 0; j < 4; ++j) { const f32x4 v = *(const f32x4*)(xr + 4 * F.lane + 256 * j); st_bf4(XA + (size_t)m * D + 4 * F.lane + 256 * j, v); }
    }
}

template <bool WF32>
__device__ __forceinline__ void ln_phase(Frame& F, float* v, const float* g, const float* bta, bf16* xn, const float* res_s, const float* P, const int SK) {
    const int gw = F.vcu * NWAVES + F.wave, NGW = F.G * NWAVES;
    for (int m = gw; m < M; m += NGW) {
        float* row = v + (size_t)m * D + 4 * F.lane;
        f32x4 x[4]; float s = 0.f;
        if (m < MP) {
#pragma unroll
            for (int j = 0; j < 4; ++j) x[j] = *(const f32x4*)(row + 256 * j);
        } else {
            const size_t ro = (size_t)(m - MP) * D + 4 * F.lane;
#pragma unroll
            for (int j = 0; j < 4; ++j) x[j] = *(const f32x4*)(res_s + ro + 256 * j) * ALPHA;
            for (int kz = 0; kz < SK; ++kz) {
#pragma unroll
                for (int j = 0; j < 4; ++j) x[j] += *(const f32x4*)(P + (size_t)kz * 1024 * 1024 + ro + 256 * j);
            }
        }
#pragma unroll
        for (int j = 0; j < 4; ++j) s += (x[j][0] + x[j][1]) + (x[j][2] + x[j][3]);
        const float mean = wave_sum(s) * (1.f / D); float s2 = 0.f;
#pragma unroll
        for (int j = 0; j < 4; ++j) { x[j] = x[j] - mean; s2 += (x[j][0] * x[j][0] + x[j][1] * x[j][1]) + (x[j][2] * x[j][2] + x[j][3] * x[j][3]); }
        const float rstd = 1.f / sqrtf(wave_sum(s2) * (1.f / D) + LN_EPS);
#pragma unroll
        for (int j = 0; j < 4; ++j) { const f32x4 gg = *(const f32x4*)(g + 4 * F.lane + 256 * j), bb = *(const f32x4*)(bta + 4 * F.lane + 256 * j);
            const f32x4 o = x[j] * rstd * gg + bb;
            if (WF32) *(f32x4*)(row + 256 * j) = o;
            st_bf4(xn + (size_t)m * D + 4 * F.lane + 256 * j, o); }
    }
}

__device__ __forceinline__ void vv_row(Frame& F, int l, int m) {
    const bf16* Z = (const bf16*)(F.ws + WS_Z); float* VV = (float*)(F.ws + WS_VV);
    const int ch = 4 * F.lane;
    f32x4 z = ld_bf4(Z + (size_t)m * NZ + ZC_VV + ch);
#pragma unroll
    for (int e = 0; e < 4; ++e) z[e] = gelu_tanh(z[e]);
    const float mean = wave_sum((z[0] + z[1]) + (z[2] + z[3])) * (1.f / 256.f);
    z = z - mean;
    const float var = wave_sum((z[0] * z[0] + z[1] * z[1]) + (z[2] * z[2] + z[3] * z[3])) * (1.f / 256.f);
    const float rstd = 1.f / sqrtf(var + LN_EPS);
    const f32x4 g = *(const f32x4*)(F.in[IN_DLG] + l * 256 + ch), b = *(const f32x4*)(F.in[IN_DLB] + l * 256 + ch);
    const f32x4 o = z * rstd * g + b;
    *(f32x4*)(VV + (size_t)m * 256 + ch) = o;
    if (m >= MP) *(f32x4*)(F.out + O_CV + ((size_t)l * MS + (m - MP)) * 256 + ch) = o;
}

__device__ __forceinline__ float log_sigmoid_(float x) { return fminf(x, 0.f) - log1pf(__expf(-fabsf(x))); }
template <bool PASS2>
__device__ __forceinline__ void gla_task(Frame& F, int l, int task, LAS float* stg) {
    const bf16* Z = (const bf16*)(F.ws + WS_Z); bf16* Y = (bf16*)(F.ws + WS_Y);
    float* SUMS = (float*)(F.ws + WS_SUMS); float* SUMP = (float*)(F.ws + WS_SUMP);
    const int lane = F.lane, h = task & 3, d = lane & 31, tt0 = lane >> 5;
    const bool samp = task >= 1024;
    const int b = task >> 7, j = (task >> 2) & 31, grp = (task - 1024) >> 2;
    const int m0 = samp ? MP + 64 * grp : b * SEQ + 64 * j;
    LAS float* sq = stg; LAS float* sk = stg + 512; LAS float* sa = stg + 1024; LAS float* sv = stg + 1536; LAS float* sg = stg + 2560;
    float w2c[16];
#pragma unroll
    for (int r = 0; r < 16; ++r) w2c[r] = F.in[IN_GW2][(l * 16 + r) * 128 + h * 32 + d];
    const float gb = F.in[IN_GB][l * 128 + h * 32 + d];
    float S[32];
#pragma unroll
    for (int i = 0; i < 32; ++i) S[i] = 0.f;
    if (PASS2 && !samp && j > 0) {
        float W = 1.f;
#pragma unroll 2
        for (int i = j - 1; i >= 0; --i) {
            const int pt = (b << 7) | (i << 2) | h;
            const float pl = SUMP[pt * 32 + d];
            const float* ds = SUMS + (size_t)pt * 2048 + lane;
#pragma unroll
            for (int dd = 0; dd < 32; ++dd) S[dd] += __shfl(W, dd) * ds[dd * 64];
            W *= pl;
        }
    }
    float pa = 1.f;
    const float gn = PASS2 ? F.in[IN_BNG][l * 256 + h * 64 + lane] : 0.f;
    for (int tb = 0; tb < 64; tb += 16) {
        LDS_WAIT(); asm volatile("" ::: "memory");
#pragma unroll
        for (int r = 0; r < 8; ++r) {
            const int t = tt0 + 2 * r; const bf16* zr = Z + (size_t)(m0 + tb + t) * NZ;
            const float qv = bf1(zr[ZC_Q + h * 32 + d]) * 0.17677669529663687f, kv = bf1(zr[ZC_K + h * 32 + d]);
            const v4u lr0 = *(const v4u*)(zr + ZC_LR), lr1 = *(const v4u*)(zr + ZC_LR + 8);
            float pre = gb;
            pre += bflo(lr0.x) * w2c[0] + bfhi(lr0.x) * w2c[1] + bflo(lr0.y) * w2c[2] + bfhi(lr0.y) * w2c[3] + bflo(lr0.z) * w2c[4] + bfhi(lr0.z) * w2c[5] + bflo(lr0.w) * w2c[6] + bfhi(lr0.w) * w2c[7];
            pre += bflo(lr1.x) * w2c[8] + bfhi(lr1.x) * w2c[9] + bflo(lr1.y) * w2c[10] + bfhi(lr1.y) * w2c[11] + bflo(lr1.z) * w2c[12] + bfhi(lr1.z) * w2c[13] + bflo(lr1.w) * w2c[14] + bfhi(lr1.w) * w2c[15];
            const float av = __expf(log_sigmoid_(pre) * (1.f / 16.f));
            pa *= av;
            sq[t * 32 + d] = qv; sk[t * 32 + d] = kv; sa[t * 32 + d] = av;
        }
#pragma unroll
        for (int t = 0; t < 16; ++t) { const bf16* zr = Z + (size_t)(m0 + tb + t) * NZ; sv[t * 64 + lane] = bf1(zr[ZC_V + h * 64 + lane]); if (PASS2) sg[t * 64 + lane] = bf1(zr[ZC_G + h * 64 + lane]); }
        LDS_WAIT(); asm volatile("" ::: "memory");
#pragma unroll 2
        for (int t = 0; t < 16; ++t) {
            if (PASS2 && samp && (t & 7) == 0) {
                const int bs = grp * 8 + ((tb + t) >> 3);
                const float* s0 = F.in[IN_SGLA] + (((size_t)l * DB + bs) * 4 + h) * 2048 + lane;
#pragma unroll
                for (int dd = 0; dd < 32; ++dd) S[dd] = s0[dd * 64];
            }
            const float vt = sv[t * 64 + lane]; float o = 0.f;
#pragma unroll
            for (int d4 = 0; d4 < 8; ++d4) {
                const f32x4 a4 = *(const LAS f32x4*)(sa + t * 32 + 4 * d4), k4 = *(const LAS f32x4*)(sk + t * 32 + 4 * d4);
                f32x4 q4 = (f32x4){0.f, 0.f, 0.f, 0.f}; if (PASS2) q4 = *(const LAS f32x4*)(sq + t * 32 + 4 * d4);
#pragma unroll
                for (int e = 0; e < 4; ++e) { S[4 * d4 + e] = a4[e] * S[4 * d4 + e] + k4[e] * vt; o += q4[e] * S[4 * d4 + e]; }
            }
            if (PASS2) {
                const int m = m0 + tb + t;
                const float ms = wave_sum(o * o) * (1.f / 64.f);
                const float on = o * (1.f / sqrtf(ms + LN_EPS)) * gn * siluf_(sg[t * 64 + lane]);
                Y[(size_t)m * D + 256 + h * 64 + lane] = (bf16)f2bf(on);
                if (samp && (t & 7) == 7) {
                    const int bs = grp * 8 + ((tb + t) >> 3);
                    float* so = F.out + O_GS + (((size_t)l * DB + bs) * 4 + h) * 2048 + lane;
#pragma unroll
                    for (int dd = 0; dd < 32; ++dd) so[dd * 64] = S[dd];
                }
            }
        }
    }
    if (!PASS2) {
        float* ds = SUMS + (size_t)task * 2048 + lane;
#pragma unroll
        for (int dd = 0; dd < 32; ++dd) ds[dd * 64] = S[dd];
        const float pt = pa * __shfl_xor(pa, 32);
        if (lane < 32) SUMP[task * 32 + d] = pt;
    } else if (!samp && j == 31) {
        float* so = F.out + O_GP + (((size_t)l * NB + b) * 4 + h) * 2048 + lane;
#pragma unroll
        for (int dd = 0; dd < 32; ++dd) so[dd * 64] = S[dd];
    }
}

__device__ __forceinline__ void sample_token(Frame& F, int l, int m) {
    const bf16* Z = (const bf16*)(F.ws + WS_Z); bf16* Y = (bf16*)(F.ws + WS_Y); const float* VV = (const float*)(F.ws + WS_VV);
    const int lane = F.lane, ch = 4 * lane;
    const int bq = (m - MP) >> 3, t = (m - MP) & 7;
    const bf16* zr = Z + (size_t)m * NZ;
    {
        const float* hist = F.in[IN_SCA] + ((size_t)l * DB + bq) * 2 * 256 + ch;
        const f32x4 ab = ld_bf4(zr + ZC_AB + ch);
        const f32x4 x2 = ld_bf4(zr + ZC_AC + ch) * ld_bf4(zr + ZC_AH + ch);
        f32x4 x1, x0;
        if (t >= 1) x1 = ld_bf4(zr - NZ + ZC_AC + ch) * ld_bf4(zr - NZ + ZC_AH + ch); else x1 = *(const f32x4*)(hist + 256);
        if (t >= 2) x0 = ld_bf4(zr - 2 * NZ + ZC_AC + ch) * ld_bf4(zr - 2 * NZ + ZC_AH + ch); else x0 = *(const f32x4*)(hist + t * 256);
        const float* w = F.in[IN_ACW] + l * 3 * 256 + ch;
        const f32x4 ya = ab * (*(const f32x4*)(w) * x0 + *(const f32x4*)(w + 256) * x1 + *(const f32x4*)(w + 512) * x2);
        st_bf4(Y + (size_t)m * D + ch, ya);
        if (t >= DSEQ - 2) *(f32x4*)(F.out + O_CAS + (((size_t)l * DB + bq) * 2 + (t - (DSEQ - 2))) * 256 + ch) = x2;
    }
    {
        const float* hist = F.in[IN_SCC] + ((size_t)l * DB + bq) * 30 * 256 + ch;
        const float* w = F.in[IN_CCW] + l * 31 * 256 + ch;
        f32x4 acc = *(const f32x4*)(F.in[IN_CCB] + l * 256 + ch);
        f32x4 cur = acc;
#pragma unroll
        for (int k = 0; k < 8; ++k) {
            if (k <= t) { const bf16* zz = zr + (ptrdiff_t)(k - t) * NZ; const f32x4 ca = ld_bf4(zz + ZC_CA + ch), cg = ld_bf4(zz + ZC_CG + ch); f32x4 val;
#pragma unroll
                for (int e = 0; e < 4; ++e) val[e] = ca[e] * sigmoidf_(cg[e]);
                acc += *(const f32x4*)(w + (30 - t + k) * 256) * val; cur = val; }
        }
#pragma unroll 6
        for (int jj = 0; jj < 30 - t; ++jj) acc += *(const f32x4*)(w + jj * 256) * *(const f32x4*)(hist + (t + jj) * 256);
        const float mean = wave_sum((acc[0] + acc[1]) + (acc[2] + acc[3])) * (1.f / 256.f);
        acc = acc - mean;
        const float var = wave_sum((acc[0] * acc[0] + acc[1] * acc[1]) + (acc[2] * acc[2] + acc[3] * acc[3])) * (1.f / 256.f);
        const float rstd = 1.f / sqrtf(var + LN_EPS);
        const f32x4 g = *(const f32x4*)(F.in[IN_CLG] + l * 256 + ch), bb = *(const f32x4*)(F.in[IN_CLB] + l * 256 + ch);
        f32x4 y = acc * rstd * g + bb;
#pragma unroll
        for (int e = 0; e < 4; ++e) y[e] = siluf_(y[e]);
        st_bf4(Y + (size_t)m * D + 512 + ch, y);
        float* o = F.out + O_CCS + ((size_t)l * DB + bq) * 30 * 256 + ch;
        *(f32x4*)(o + (22 + t) * 256) = cur;
#pragma unroll
        for (int k = 0; k < 3; ++k) { const int i = t + 8 * k; if (i < 22) *(f32x4*)(o + i * 256) = *(const f32x4*)(hist + (8 + i) * 256); }
    }
    {
        f32x4 u = ld_bf4(zr + ZC_U + ch);
#pragma unroll
        for (int e = 0; e < 4; ++e) u[e] = gelu_tanh(u[e]);
        const int g = lane >> 4;
        const float* wrow = F.in[IN_DWS] + (((size_t)l * 4 + g) * 128 + t) * 128;
        const float bias = F.in[IN_DBS][(l * 4 + g) * 128 + t];
        f32x4 f = (f32x4){bias, bias, bias, bias};
        const float* vrow = VV + (size_t)(m - t) * 256 + ch;
#pragma unroll
        for (int s = 0; s < 8; ++s) if (s <= t) f += wrow[s] * *(const f32x4*)(vrow + (size_t)s * 256);
        st_bf4(Y + (size_t)m * D + 768 + ch, u * f);
    }
}

typedef short bf16x8v __attribute__((ext_vector_type(8)));
typedef short s16x4v __attribute__((ext_vector_type(4)));
constexpr int VV_PITCH = 544;
__device__ __forceinline__ s16x4v tr_read16(const LAS unsigned char* p) { return __builtin_bit_cast(s16x4v, __builtin_amdgcn_ds_read_tr16_b64_v4i16((LAS s16x4v*)p)); }
__device__ __forceinline__ void pd_job(Frame& F, int l, int chunk) {
    const bf16* Z = (const bf16*)(F.ws + WS_Z); bf16* Y = (bf16*)(F.ws + WS_Y);
    const int lane = F.lane, m0 = chunk * 128;
    LAS unsigned char* vvb = F.lds + RING_OFF;
    {
        const int ch = 4 * lane;
        const f32x4 g = *(const f32x4*)(F.in[IN_DLG] + l * 256 + ch), b = *(const f32x4*)(F.in[IN_DLB] + l * 256 + ch);
        v2u zraw[16];
#pragma unroll
        for (int i = 0; i < 16; ++i) zraw[i] = *(const v2u*)(Z + (size_t)(m0 + F.wave + 8 * i) * NZ + ZC_VV + ch);
#pragma unroll
        for (int i = 0; i < 16; ++i) {
            const int s = F.wave + 8 * i;
            f32x4 z = (f32x4){bflo(zraw[i].x), bfhi(zraw[i].x), bflo(zraw[i].y), bfhi(zraw[i].y)};
#pragma unroll
            for (int e = 0; e < 4; ++e) z[e] = gelu_tanh(z[e]);
            const float mean = wave_sum((z[0] + z[1]) + (z[2] + z[3])) * (1.f / 256.f);
            z = z - mean;
            const float var = wave_sum((z[0] * z[0] + z[1] * z[1]) + (z[2] * z[2] + z[3] * z[3])) * (1.f / 256.f);
            const f32x4 o = z * (1.f / sqrtf(var + LN_EPS)) * g + b;
            v2u w; w.x = pk2(o[0], o[1]); w.y = pk2(o[2], o[3]);
            *(LAS v2u*)(vvb + s * VV_PITCH + 8 * lane) = w;
        }
    }
    __syncthreads();
    {
        const int g = F.wave & 3, par = F.wave >> 2, fr = lane & 15, fq = lane >> 4;
        const float* Wg = F.in[IN_DWS] + ((size_t)l * 4 + g) * 128 * 128;
        const float* bs = F.in[IN_DBS] + (l * 4 + g) * 128;
#pragma unroll
        for (int mi = 0; mi < 4; ++mi) {
            const int mb = 2 * mi + par, t = 16 * mb + fr;
            pg8::f32x4 acc[4];
#pragma unroll
            for (int nb = 0; nb < 4; ++nb) acc[nb] = (pg8::f32x4){0.f, 0.f, 0.f, 0.f};
#pragma unroll
            for (int ks = 0; ks <= mi; ++ks) {
                const int kb = 32 * ks + 8 * fq;
                const float* wp = Wg + (size_t)t * 128 + kb;
                const f32x4 w0 = *(const f32x4*)wp, w1 = *(const f32x4*)(wp + 4);
                float wv[8] = {w0[0], w0[1], w0[2], w0[3], w1[0], w1[1], w1[2], w1[3]};
#pragma unroll
                for (int e = 0; e < 8; ++e) wv[e] = (kb + e <= t) ? wv[e] : 0.f;
                v4u ap; ap.x = pk2(wv[0], wv[1]); ap.y = pk2(wv[2], wv[3]); ap.z = pk2(wv[4], wv[5]); ap.w = pk2(wv[6], wv[7]);
                const bf16x8v af = __builtin_bit_cast(bf16x8v, ap);
                const LAS unsigned char* rb = vvb + (32 * ks + 8 * fq + (fr >> 2)) * VV_PITCH + 2 * (g * 64) + 8 * (lane & 3);
#pragma unroll
                for (int nb = 0; nb < 4; ++nb) {
                    const s16x4v lo = tr_read16(rb + 32 * nb), hi = tr_read16(rb + 4 * VV_PITCH + 32 * nb);
                    const bf16x8v bfv = (bf16x8v){lo[0], lo[1], lo[2], lo[3], hi[0], hi[1], hi[2], hi[3]};
                    acc[nb] = __builtin_amdgcn_mfma_f32_16x16x32_bf16(bfv, af, acc[nb], 0, 0, 0);
                }
            }
            const float bias = bs[t];
            const bf16* zu = Z + (size_t)(m0 + t) * NZ + ZC_U + g * 64 + 4 * fq;
            bf16* yo = Y + (size_t)(m0 + t) * D + 768 + g * 64 + 4 * fq;
#pragma unroll
            for (int nb = 0; nb < 4; ++nb) {
                f32x4 u = ld_bf4(zu + 16 * nb);
#pragma unroll
                for (int e = 0; e < 4; ++e) u[e] = gelu_tanh(u[e]) * (acc[nb][e] + bias);
                st_bf4(yo + 16 * nb, u);
            }
        }
    }
    __syncthreads();
}

__device__ __forceinline__ void pc_job(Frame& F, int l, int unit) {
    const bf16* Z = (const bf16*)(F.ws + WS_Z); bf16* Y = (bf16*)(F.ws + WS_Y);
    const int lane = F.lane, m0 = unit * 64, b = m0 >> 11, t0 = m0 & 2047, ch = 4 * lane;
    LAS float* pc = (LAS float*)(F.lds + RING_OFF);
    LAS float* wl = (LAS float*)(F.lds + RING_OFF + 94 * 1024);
    const f32x4 zero4 = (f32x4){0.f, 0.f, 0.f, 0.f};
    for (int i = F.tid; i < 31 * 64; i += NWAVES * 64) *(LAS f32x4*)(wl + 4 * i) = *(const f32x4*)(F.in[IN_CCW] + l * 31 * 256 + 4 * i);
    {
        v2u ca[12], cg[12];
        const v2u z2 = (v2u){0u, 0u};
#pragma unroll
        for (int k = 0; k < 12; ++k) {
            const int i = F.wave + 8 * k, t = t0 - 30 + i;
            if (i < 94 && t >= 0) { const bf16* zz = Z + ((size_t)b * SEQ + t) * NZ + ch; ca[k] = *(const v2u*)(zz + ZC_CA); cg[k] = *(const v2u*)(zz + ZC_CG); } else { ca[k] = z2; cg[k] = z2; }
        }
#pragma unroll
        for (int k = 0; k < 12; ++k) {
            const int i = F.wave + 8 * k, t = t0 - 30 + i;
            if (i < 94) {
                f32x4 v;
                v[0] = bflo(ca[k].x) * sigmoidf_(bflo(cg[k].x)); v[1] = bfhi(ca[k].x) * sigmoidf_(bfhi(cg[k].x)); v[2] = bflo(ca[k].y) * sigmoidf_(bflo(cg[k].y)); v[3] = bfhi(ca[k].y) * sigmoidf_(bfhi(cg[k].y));
                *(LAS f32x4*)(pc + i * 256 + ch) = v;
                if (t >= SEQ - 30) *(f32x4*)(F.out + O_CCP + (((size_t)l * NB + b) * 30 + (t - (SEQ - 30))) * 256 + ch) = v;
            }
        }
    }
    __syncthreads();
    {
        const f32x4 cb = *(const f32x4*)(F.in[IN_CCB] + l * 256 + ch);
        const f32x4 g = *(const f32x4*)(F.in[IN_CLG] + l * 256 + ch), bb = *(const f32x4*)(F.in[IN_CLB] + l * 256 + ch);
#pragma unroll 1
        for (int qd = 0; qd < 2; ++qd) {
            const int tq = 8 * F.wave + 4 * qd;
            f32x4 acc[4] = {cb, cb, cb, cb};
            const LAS float* pr = pc + tq * 256 + ch;
            f32x4 r0 = *(const LAS f32x4*)(pr), r1 = *(const LAS f32x4*)(pr + 256), r2 = *(const LAS f32x4*)(pr + 512);
#pragma unroll
            for (int j = 0; j < 31; ++j) {
                const f32x4 r3 = *(const LAS f32x4*)(pr + (j + 3) * 256), w = *(const LAS f32x4*)(wl + j * 256 + ch);
                acc[0] += w * r0; acc[1] += w * r1; acc[2] += w * r2; acc[3] += w * r3;
                r0 = r1; r1 = r2; r2 = r3;
            }
#pragma unroll
            for (int k = 0; k < 4; ++k) {
                f32x4 a = acc[k];
                const float mean = wave_sum((a[0] + a[1]) + (a[2] + a[3])) * (1.f / 256.f);
                a = a - mean;
                const float var = wave_sum((a[0] * a[0] + a[1] * a[1]) + (a[2] * a[2] + a[3] * a[3])) * (1.f / 256.f);
                f32x4 y = a * (1.f / sqrtf(var + LN_EPS)) * g + bb;
#pragma unroll
                for (int e = 0; e < 4; ++e) y[e] = siluf_(y[e]);
                st_bf4(Y + (size_t)(m0 + tq + k) * D + 512 + ch, y);
            }
        }
    }
    {
        const float* w = F.in[IN_ACW] + l * 3 * 256 + ch;
        const f32x4 w0 = *(const f32x4*)(w), w1 = *(const f32x4*)(w + 256), w2 = *(const f32x4*)(w + 512);
#pragma unroll 4
        for (int k = 0; k < 8; ++k) {
            const int tau = 8 * F.wave + k, t = t0 + tau; const bf16* zr = Z + (size_t)(m0 + tau) * NZ;
            const f32x4 ab = ld_bf4(zr + ZC_AB + ch);
            const f32x4 x2 = ld_bf4(zr + ZC_AC + ch) * ld_bf4(zr + ZC_AH + ch);
            const f32x4 x1 = (t >= 1) ? ld_bf4(zr - NZ + ZC_AC + ch) * ld_bf4(zr - NZ + ZC_AH + ch) : zero4;
            const f32x4 x0 = (t >= 2) ? ld_bf4(zr - 2 * NZ + ZC_AC + ch) * ld_bf4(zr - 2 * NZ + ZC_AH + ch) : zero4;
            st_bf4(Y + (size_t)(m0 + tau) * D + ch, ab * (w0 * x0 + w1 * x1 + w2 * x2));
            if (t >= SEQ - 2) *(f32x4*)(F.out + O_CAP + (((size_t)l * NB + b) * 2 + (t - (SEQ - 2))) * 256 + ch) = x2;
        }
    }
    __syncthreads();
}
#ifndef REP_M1
#define REP_M1 1
#endif
#ifndef REP_M2
#define REP_M2 1
#endif
constexpr int PH_PER_LAYER = 8, N_PHASES = 1 + 2 * PH_PER_LAYER;
#define IN(k) (lo <= (k) && (k) < hi)
#define SEAM(k) do { if (IN(k) && IN((k) + 1)) xcd_barrier(bar); } while (0)
template <int L> __device__ __forceinline__ void layer_phases(Frame& F, const Args& args, const XcdBarrier& bar, const int lo, const int hi, const int gw, const int NGW) {
        constexpr int l = L; constexpr int p0 = 1 + L * PH_PER_LAYER;
        unsigned char* wl = args.ws + WS_W + (size_t)l * W_LAYER;
        bf16* XA = (bf16*)(args.ws + WS_XNA); bf16* XB = (bf16*)(args.ws + WS_XNB);
        float* yout = args.out + O_Y;
        if (IN(p0 + 0)) {
            pg8::Gemm g{XA, (const bf16*)(wl + W_IN_OFF), M, NZ, D, D, 0}; pg8::StaticOrder S; S.init(M, NZ, F.G, (int)blockIdx.x);
            pg8::EpiBf16<0> E{(bf16*)(args.ws + WS_Z), NZ};
            pg8::gemm_phase<pg8::EpiBf16<0>, pg8::StaticOrder, true, true>(F.lds + RING_OFF, g, S, E);
            SEAM(p0 + 0);
        }
        if (IN(p0 + 1)) {
            for (int rep = 0; rep < REP_M1; ++rep) {
            for (int m = MP + gw; m < M; m += NGW) vv_row(F, l, m);
            LAS float* stg = (LAS float*)(F.lds + RING_OFF + F.wave * 16384);
            for (int task = gw; task < 1024; task += NGW) gla_task<false>(F, l, task, stg);
            }
            SEAM(p0 + 1);
        }
        if (IN(p0 + 2)) {
            for (int rep = 0; rep < REP_M2; ++rep) {
            for (int job = F.vcu; job < 128 + 256; job += F.G) { if (job < 128) pd_job(F, l, job); else pc_job(F, l, job - 128); }
            LAS float* stg = (LAS float*)(F.lds + RING_OFF + F.wave * 16384);
            const int gwr = (gw + NGW / 2) % NGW;
            for (int task = gwr; task < 1088; task += NGW) gla_task<true>(F, l, task, stg);
            for (int m = MP + gw; m < M; m += NGW) sample_token(F, l, m);
            }
            SEAM(p0 + 2);
        }
        float* Pout = (float*)(args.ws + WS_Z);
        float* Pff2 = (float*)(args.ws + WS_XNB);
        if (IN(p0 + 3)) {
            { pg8::Gemm g{(const bf16*)(args.ws + WS_Y), (const bf16*)(wl + W_OUT_OFF), MP, D, D, D, 0}; pg8::StaticOrder S; S.init(MP, D, F.G, (int)blockIdx.x);
              pg8::EpiRes E{l == 0 ? args.in[IN_XP] : yout, nullptr, MP, yout, D, ALPHA};
              pg8::gemm_phase<pg8::EpiRes, pg8::StaticOrder, true, true>(F.lds + RING_OFF, g, S, E); }
            { pg8::Gemm g{(const bf16*)(args.ws + WS_Y), (const bf16*)(wl + W_OUT_OFF), M, D, 256, D, 256}; pg8::SplitOrder S; S.init(4, F.G, (int)blockIdx.x);
              pg8::EpiPart E{Pout};
              pg8::gemm_phase<pg8::EpiPart, pg8::SplitOrder, true, true>(F.lds + RING_OFF, g, S, E); }
            SEAM(p0 + 3);
        }
        if (IN(p0 + 4)) { ln_phase<true>(F, yout, args.in[IN_L1G] + l * D, args.in[IN_L1B] + l * D, XB, l == 0 ? args.in[IN_XS] : yout + (size_t)MP * D, Pout, 4); SEAM(p0 + 4); }
        if (IN(p0 + 5)) {
            pg8::Gemm g{XB, (const bf16*)(wl + W_FF1_OFF), M, FF, D, D, 0}; pg8::StaticOrder S; S.init(M, FF, F.G, (int)blockIdx.x);
            pg8::EpiBf16<2> E{(bf16*)(args.ws + WS_H), FF};
            pg8::gemm_phase<pg8::EpiBf16<2>, pg8::StaticOrder, true, true>(F.lds + RING_OFF, g, S, E);
            SEAM(p0 + 5);
        }
        if (IN(p0 + 6)) {
            { pg8::Gemm g{(const bf16*)(args.ws + WS_H), (const bf16*)(wl + W_FF2_OFF), MP, D, FF, FF, 0}; pg8::StaticOrder S; S.init(MP, D, F.G, (int)blockIdx.x);
              pg8::EpiRes E{yout, nullptr, MP, yout, D, ALPHA};
              pg8::gemm_phase<pg8::EpiRes, pg8::StaticOrder, true, true>(F.lds + RING_OFF, g, S, E); }
            { pg8::Gemm g{(const bf16*)(args.ws + WS_H), (const bf16*)(wl + W_FF2_OFF), M, D, 512, FF, 512}; pg8::SplitOrder S; S.init(8, F.G, (int)blockIdx.x);
              pg8::EpiPart E{Pff2};
              pg8::gemm_phase<pg8::EpiPart, pg8::SplitOrder, true, true>(F.lds + RING_OFF, g, S, E); }
            SEAM(p0 + 6);
        }
        if (IN(p0 + 7)) { ln_phase<true>(F, yout, args.in[IN_L2G] + l * D, args.in[IN_L2B] + l * D, XA, yout + (size_t)MP * D, Pff2, 8); SEAM(p0 + 7); }
}
__global__ void __launch_bounds__(NWAVES * 64, 2) mk_fwd(Args args) {
    extern __shared__ __attribute__((aligned(16))) unsigned char lds[];
    Frame F;
    F.lds = (LAS unsigned char*)lds;
    F.MISC = (volatile LAS unsigned*)(F.lds + MISC_OFF);
    F.tid = threadIdx.x; F.lane = F.tid & 63; F.wave = __builtin_amdgcn_readfirstlane(F.tid >> 6);
    F.G = gridDim.x; { const int bx = blockIdx.x; F.vcu = (F.G % 8 == 0) ? (bx % 8) * (F.G / 8) + bx / 8 : bx; }
    F.in = args.in; F.out = args.out; F.ws = args.ws;
    gu32* ctl = (gu32*)(args.ws + WS_CTL);
    for (int u = F.tid; u < (LDS_BYTES - LDSCTL_OFF) / 4; u += NWAVES * 64) ((LAS unsigned*)(F.lds + LDSCTL_OFF))[u] = 0u;
    __syncthreads();
    XcdBarrier bar; bar.bar = (unsigned*)(ctl + CW_BAR); bar.x = 0; bar.st = nullptr;
    const int lo = args.ph_lo, hi = args.ph_hi;
    const bool one_launch = (hi - lo) > 1;
    if (one_launch) bar = xcd_barrier_post((unsigned*)(ctl + CW_BAR), F.MISC + 8);
    const int gw = F.vcu * NWAVES + F.wave, NGW = F.G * NWAVES;

    if (IN(0)) { p0_prologue(F); SEAM(0); }

    layer_phases<0>(F, args, bar, lo, hi, gw, NGW);
    layer_phases<1>(F, args, bar, lo, hi, gw, NGW);
#undef IN
#undef SEAM
}

extern "C" void kernel_launch(void* const* d_in, const int* in_sizes, int n_in, void* d_out, int out_size, void* d_ws, size_t ws_size, hipStream_t stream) {
    static int grid = 0;
    if (grid == 0) {
        if (n_in != 25 || (size_t)out_size != O_END || ws_size < WS_END) { fprintf(stderr, "kernel_launch: unexpected sizes n_in %d out %d ws %zu\n", n_in, out_size, ws_size); grid = -1; return; }
        int dev = 0, cus = 0;
        if (hipGetDevice(&dev) != hipSuccess || hipDeviceGetAttribute(&cus, hipDeviceAttributeMultiprocessorCount, dev) != hipSuccess) { grid = -1; return; }
        if (hipFuncSetAttribute((const void*)mk_fwd, hipFuncAttributeMaxDynamicSharedMemorySize, LDS_BYTES) != hipSuccess) { fprintf(stderr, "kernel_launch: hipFuncSetAttribute failed\n"); grid = -1; return; }
        (void)hipGetLastError();
        grid = cus;
    }
    if (grid < 0) return;
    (void)hipMemsetAsync((char*)d_ws + WS_CTL, 0, CTL_ZERO_BYTES, stream);
    Args a{};
    for (int i = 0; i < 25; ++i) a.in[i] = (const float*)d_in[i];
    a.out = (float*)d_out; a.ws = (unsigned char*)d_ws;
#if MK_N_LAUNCHES == 1
    a.ph_lo = 0; a.ph_hi = N_PHASES;
    hipLaunchKernelGGL(mk_fwd, dim3(grid), dim3(NWAVES * 64), LDS_BYTES, stream, a);
#else
    for (int p = 0; p < N_PHASES; ++p) { a.ph_lo = p; a.ph_hi = p + 1; hipLaunchKernelGGL(mk_fwd, dim3(grid), dim3(NWAVES * 64), LDS_BYTES, stream, a); }
#endif
}
```
